# Optimizing an MI355X kernel written in HIP

```python
import jax, jax.numpy as jnp
from jax import lax
import numpy as np

D_MODEL = 1024
BATCH = 2
SEQ = 16384
DEPTH = 4
DEC_BATCH = 8
DEC_SEQ = 32
PAST_LEN = 4096

CHUNK = 64
D_MIX = D_MODEL
D_A = D_MIX // 2
N_A_HEADS = 4
A_HEAD_DIM = D_A // N_A_HEADS
GMLP_CHUNK = 128
D_B = D_MIX // 4
POOL_WINDOWS = (2, 4, 8, 16)
N_POOL_GROUPS = len(POOL_WINDOWS)
POOL_GROUP = D_B // N_POOL_GROUPS
POOL_HIST = max(POOL_WINDOWS) - 1
D_C = D_MIX - D_A - D_B
CONV_W = 3
CONV_HIST = CONV_W - 1
D_IN = 2 * D_A + D_B + 3 * D_C
D_FF = 11 * D_MODEL // 4
EPS = 1e-6

kernel_name = 'hybrid_stream_gmlp_pool_shortconv'


def _rmsnorm(x, g):
    xf = x.astype(jnp.float32)
    y = xf * lax.rsqrt(jnp.mean(xf * xf, axis=-1, keepdims=True) + EPS)
    return (y * g.astype(jnp.float32)).astype(x.dtype)


def _causal_dwconv3(ext, w):
    return w[0] * ext[:, :-2] + w[1] * ext[:, 1:-1] + w[2] * ext[:, 2:]


def _chunk_spatial_gate(u, v, w_s, b_s):
    b, T, _ = v.shape
    L = min(T, GMLP_CHUNK)
    n = T // L
    mask = jnp.tril(jnp.ones((L, L), dtype=w_s.dtype))
    w = w_s[:, :L, :L] * mask
    vh = v.reshape(b, n, L, N_A_HEADS, A_HEAD_DIM)
    s = jnp.einsum('hqk,bnkhd->bnqhd', w, vh) + b_s[:, :L].T[:, :, None]
    return u * s.reshape(b, T, D_A)


def _multiscale_pool(p_ext, pos0, w_pool, scale):
    b, Lx, _ = p_ext.shape
    T = Lx - POOL_HIST
    pf = p_ext.astype(jnp.float32)
    cs = jnp.concatenate([jnp.zeros((b, 1, D_B), jnp.float32), lax.cumsum(pf, axis=1)], axis=1)
    end = cs[:, POOL_HIST + 1:]
    pos = pos0 + jnp.arange(T)
    means = []
    for gi, w in enumerate(POOL_WINDOWS):
        sl = slice(gi * POOL_GROUP, (gi + 1) * POOL_GROUP)
        start = cs[:, POOL_HIST + 1 - w: POOL_HIST + 1 - w + T, sl]
        cnt = jnp.minimum(pos + 1, w).astype(jnp.float32)[None, :, None]
        means.append((end[..., sl] - start) / cnt)
    d = (jnp.concatenate(means, axis=-1) - pf[:, POOL_HIST:]).reshape(b, T, N_POOL_GROUPS, POOL_GROUP)
    y = jnp.einsum('btgc,gcd->btgd', d, w_pool.astype(jnp.float32)).reshape(b, T, D_B)
    return (y * scale.astype(jnp.float32)).astype(p_ext.dtype)


def _layer(x, pool_hist, conv_hist, ffn_hist, pos0, g1, w_in, w_s, b_s, w_pool, pool_scale,
           w_conv, w_out, g2, w_up, w_fconv, b_fconv, w_down):
    h = _rmsnorm(x, g1)
    z = h @ w_in
    cuts = [D_A, 2 * D_A, 2 * D_A + D_B, 2 * D_A + D_B + D_C, 2 * D_A + D_B + 2 * D_C]
    u_a, v_a, p_b, gate_b, gate_c, h_c = jnp.split(z, cuts, axis=-1)
    y_a = _chunk_spatial_gate(u_a, v_a, w_s, b_s)
    p_ext = jnp.concatenate([pool_hist, p_b], axis=1)
    y_b = _multiscale_pool(p_ext, pos0, w_pool, pool_scale)
    q_ext = jnp.concatenate([conv_hist, gate_c * h_c], axis=1)
    y_c = gate_b * _causal_dwconv3(q_ext, w_conv)
    x = x + jnp.concatenate([y_a, y_b, y_c], axis=-1) @ w_out
    h2 = _rmsnorm(x, g2)
    up_ext = jnp.concatenate([ffn_hist, h2 @ w_up], axis=1)
    upc = _causal_dwconv3(up_ext, w_fconv) + b_fconv
    g, a = jnp.split(upc, 2, axis=-1)
    x = x + (jax.nn.silu(g) * a) @ w_down
    return x, p_ext[:, -POOL_HIST:], q_ext[:, -CONV_HIST:], up_ext[:, -CONV_HIST:], v_a


def setup_inputs(seed: int = 0) -> dict:
    key = jax.random.key(seed)
    ks = jax.random.split(key, 24)
    f32 = jnp.float32
    nrm = lambda k, s, sc: jax.random.normal(k, s, f32) * sc
    return {
        'x_prompt': nrm(ks[0], (BATCH, SEQ, D_MODEL), 1.0),
        'x_sample': nrm(ks[1], (DEC_BATCH, DEC_SEQ, D_MODEL), 1.0),
        'state_pool': nrm(ks[2], (DEPTH, DEC_BATCH, POOL_HIST, D_B), 1.0),
        'state_conv': nrm(ks[3], (DEPTH, DEC_BATCH, CONV_HIST, D_C), 1.0),
        'state_ffn_conv': nrm(ks[4], (DEPTH, DEC_BATCH, CONV_HIST, 2 * D_FF), 1.0),
        'norm1_g': 1.0 + nrm(ks[5], (DEPTH, D_MODEL), 0.02),
        'w_in': nrm(ks[6], (DEPTH, D_MODEL, D_IN), D_MODEL ** -0.5),
        'w_s': nrm(ks[7], (DEPTH, N_A_HEADS, GMLP_CHUNK, GMLP_CHUNK), 0.5 * GMLP_CHUNK ** -0.5),
        'b_s': 1.0 + nrm(ks[8], (DEPTH, N_A_HEADS, GMLP_CHUNK), 0.1),
        'w_pool': nrm(ks[9], (DEPTH, N_POOL_GROUPS, POOL_GROUP, POOL_GROUP), POOL_GROUP ** -0.5),
        'pool_scale': 1.0 + nrm(ks[10], (DEPTH, D_B), 0.1),
        'w_conv': nrm(ks[11], (DEPTH, CONV_W, D_C), CONV_W ** -0.5),
        'w_out': nrm(ks[12], (DEPTH, D_MIX, D_MODEL), D_MIX ** -0.5),
        'norm2_g': 1.0 + nrm(ks[13], (DEPTH, D_MODEL), 0.02),
        'w_up': nrm(ks[14], (DEPTH, D_MODEL, 2 * D_FF), D_MODEL ** -0.5),
        'w_fconv': nrm(ks[15], (DEPTH, CONV_W, 2 * D_FF), CONV_W ** -0.5),
        'b_fconv': nrm(ks[16], (DEPTH, 2 * D_FF), 0.02),
        'w_down': nrm(ks[17], (DEPTH, D_FF, D_MODEL), D_FF ** -0.5),
        'final_g': 1.0 + nrm(ks[18], (D_MODEL,), 0.02),
    }


def reference(x_prompt, x_sample, state_pool, state_conv, state_ffn_conv, norm1_g, w_in, w_s, b_s,
              w_pool, pool_scale, w_conv, w_out, norm2_g, w_up, w_fconv, b_fconv, w_down, final_g):
    xp, xs = x_prompt, x_sample
    bp = xp.shape[0]
    zero_pool = jnp.zeros((bp, POOL_HIST, D_B), xp.dtype)
    zero_conv = jnp.zeros((bp, CONV_HIST, D_C), xp.dtype)
    zero_ffn = jnp.zeros((bp, CONV_HIST, 2 * D_FF), xp.dtype)
    pool_p, conv_p, ffn_p = [], [], []
    pool_s, conv_s, ffn_s, chunk_v_s = [], [], [], []
    for l in range(DEPTH):
        params = (norm1_g[l], w_in[l], w_s[l], b_s[l], w_pool[l], pool_scale[l], w_conv[l], w_out[l],
                  norm2_g[l], w_up[l], w_fconv[l], b_fconv[l], w_down[l])
        xp, pp, cp, fp, _ = _layer(xp, zero_pool, zero_conv, zero_ffn, 0, *params)
        xs, ps, cs, fs, vs = _layer(xs, state_pool[l], state_conv[l], state_ffn_conv[l], PAST_LEN, *params)
        pool_p.append(pp); conv_p.append(cp); ffn_p.append(fp)
        pool_s.append(ps); conv_s.append(cs); ffn_s.append(fs); chunk_v_s.append(vs)
    y_prompt = _rmsnorm(xp, final_g)
    y_sample = _rmsnorm(xs, final_g)
    return (y_prompt, y_sample, jnp.stack(pool_p), jnp.stack(conv_p), jnp.stack(ffn_p),
            jnp.stack(pool_s), jnp.stack(conv_s), jnp.stack(ffn_s), jnp.stack(chunk_v_s))
```

```cpp
#include <hip/hip_runtime.h>
#include <hip/hip_cooperative_groups.h>
#include <cstdio>
#include <cstdint>
namespace cg = cooperative_groups;

#define LAS __attribute__((address_space(3)))
typedef unsigned short bf16_t;
typedef short bf16x8 __attribute__((ext_vector_type(8)));
typedef float f32x4 __attribute__((ext_vector_type(4)));
typedef float f32x2 __attribute__((ext_vector_type(2)));
typedef unsigned u32x4 __attribute__((ext_vector_type(4)));
typedef unsigned u32x2 __attribute__((ext_vector_type(2)));

constexpr int D = 1024, DIN = 2048, DFF = 2816, DUP = 5632, NLAYER = 4;
constexpr int RP = 32768, RS = 256, R = RP + RS, SEQ = 16384, DSEQ = 32, NBP = 2, NBS = 8;
constexpr float EPS = 1e-6f;
constexpr int NSEG = R / 64;
constexpr size_t WS_WIN = 0;
constexpr size_t WS_WOUT = WS_WIN + (size_t)NLAYER * DIN * D * 2;
constexpr size_t WS_WUP = WS_WOUT + (size_t)NLAYER * D * D * 2;
constexpr size_t WS_WDN = WS_WUP + (size_t)NLAYER * DUP * D * 2;
constexpr size_t WS_WPT = WS_WDN + (size_t)NLAYER * D * DFF * 2;
constexpr size_t WS_WSB = WS_WPT + (size_t)NLAYER * 4 * 64 * 64 * 2;
constexpr size_t WS_SSQ = WS_WSB + (size_t)NLAYER * 4 * 128 * 128 * 2;
constexpr size_t WS_XB = WS_SSQ + (size_t)R * 16 * 4;
constexpr size_t WS_HALO = WS_XB + (size_t)R * D * 2;
constexpr size_t WS_HALOS = WS_HALO + (size_t)NSEG * 4 * DUP * 4;
constexpr size_t WS_BIG = WS_HALOS + (size_t)4 * 4 * DUP * 4;
constexpr size_t WS_Z = WS_BIG;
constexpr size_t WS_Y = WS_Z + (size_t)R * DIN * 2;
constexpr size_t WS_ACT = WS_BIG;
constexpr size_t WS_BAR = WS_Y + (size_t)R * D * 2;
constexpr size_t WS_END = WS_BAR + 16384;
static_assert((size_t)R * DFF * 2 <= WS_BAR - WS_BIG, "ACT overlay");
constexpr size_t O_Y = 0;
constexpr size_t O_POOLP = (size_t)R * D;
constexpr size_t O_CONVP = O_POOLP + (size_t)NLAYER * NBP * 15 * 256;
constexpr size_t O_FFNP = O_CONVP + (size_t)NLAYER * NBP * 2 * 256;
constexpr size_t O_POOLS = O_FFNP + (size_t)NLAYER * NBP * 2 * DUP;
constexpr size_t O_CONVS = O_POOLS + (size_t)NLAYER * NBS * 15 * 256;
constexpr size_t O_FFNS = O_CONVS + (size_t)NLAYER * NBS * 2 * 256;
constexpr size_t O_VS = O_FFNS + (size_t)NLAYER * NBS * 2 * DUP;
constexpr size_t O_END = O_VS + (size_t)NLAYER * NBS * DSEQ * 512;

constexpr int LDS_BYTES = 144 * 1024;

__device__ __forceinline__ unsigned cvt_pk_bf16(float lo, float hi) { unsigned r; asm volatile("v_cvt_pk_bf16_f32 %0, %1, %2" : "=v"(r) : "v"(lo), "v"(hi)); return r; }
__device__ __forceinline__ float bf_lo(unsigned w) { return __uint_as_float(w << 16); }
__device__ __forceinline__ float bf_hi(unsigned w) { return __uint_as_float(w & 0xffff0000u); }
__device__ __forceinline__ float dpp_ror1(float v) { return __int_as_float(__builtin_amdgcn_update_dpp(0, __float_as_int(v), 0x121, 0xf, 0xf, false)); }
__device__ __forceinline__ float dpp_ror2(float v) { return __int_as_float(__builtin_amdgcn_update_dpp(0, __float_as_int(v), 0x122, 0xf, 0xf, false)); }
__device__ __forceinline__ float wave_sum(float v) {
#pragma unroll
    for (int o = 1; o < 64; o <<= 1) v += __shfl_xor(v, o);
    return v;
}
__device__ __forceinline__ float rstd_of(const float* ssq_row) {
    const f32x4 a = *(const f32x4*)(ssq_row), b = *(const f32x4*)(ssq_row + 4), c = *(const f32x4*)(ssq_row + 8), d = *(const f32x4*)(ssq_row + 12);
    const float s = ((a.x + a.y) + (a.z + a.w)) + ((b.x + b.y) + (b.z + b.w)) + ((c.x + c.y) + (c.z + c.w)) + ((d.x + d.y) + (d.z + d.w));
    return rsqrtf(s * (1.0f / D) + EPS);
}

__device__ __forceinline__ void row_rstd_to_lds(const float* ssq, int pm, LAS float* rl) {
    int tid = threadIdx.x; asm volatile("" : "+v"(tid)); const int row = tid >> 1;
    const float* sp = ssq + ((size_t)pm * 256 + row) * 16 + (tid & 1) * 8;
    const f32x4 a = *(const f32x4*)sp, b = *(const f32x4*)(sp + 4);
    float s = ((a.x + a.y) + (a.z + a.w)) + ((b.x + b.y) + (b.z + b.w));
    s += __shfl_xor(s, 1);
    if ((tid & 1) == 0) rl[row] = rsqrtf(s * (1.0f / D) + EPS);
    asm volatile("s_waitcnt lgkmcnt(0)" ::: "memory"); __builtin_amdgcn_s_barrier(); asm volatile("" ::: "memory");
}

namespace pg8 {
constexpr int BM = 256, BK = 64, HALF = 128, HTB = HALF * BK * 2, STAGE_BYTES = 8 * HTB;
__host__ __device__ __forceinline__ int lds_byte(int r, int c) { const int st = (r >> 4) * 2 + (c >> 5), rr = r & 15, cc = c & 31, ob = rr * 64 + cc * 2; return st * 1024 + (ob ^ (((ob >> 9) & 1) << 5)); }
__host__ __device__ __forceinline__ void stage_rc(int b, int& R_, int& C) { const int st = b / 1024, sb = b % 1024, swz = sb ^ (((sb >> 9) & 1) << 5); R_ = (st >> 1) * 16 + swz / 64; C = (st & 1) * 32 + (swz % 64) / 2; }
__host__ __device__ __forceinline__ int perm32(int rho) { const int n = rho >> 4, i = rho & 15; return 8 * (i >> 2) + 4 * n + (i & 3); }

struct Unit { int pm, pn; };
struct Gemm { const bf16_t* A; const bf16_t* Bt; int K; };

struct Order {
    int nN, nwgP, nwg, G, c;
    __device__ __forceinline__ void init(int N, int G_, int c_) { nN = N / BM; nwgP = 128 * nN; nwg = nwgP; G = G_; c = c_; }
    __device__ __forceinline__ bool next(int i, Unit& u) const {
        const int L = i * G + c; if (L >= nwg) return false;
        if (L >= nwgP) { u.pm = 128; u.pn = L - nwgP; return true; }
        const int q = nwgP / 8; const int wgid = (L % 8) * q + L / 8;
        const int nig = 8 * nN, gid = wgid / nig, w = wgid % nig;
        u.pm = gid * 8 + (w % 8); u.pn = w / 8; return true;
    }
    __device__ __forceinline__ void a_ready(const Unit&) const {}
    __device__ __forceinline__ void done(const Unit&) const {}
};

template <class Epi, class Sched, bool ALIGN_EPI = false, bool SP2 = false>
__device__ __forceinline__ void gemm_phase(LAS unsigned char* lds, const Gemm g, const Sched& S, const Epi& E) {
    int tid = threadIdx.x; asm volatile("" : "+v"(tid));
    const int wid = __builtin_amdgcn_readfirstlane(tid >> 6), lane = tid & 63, wr = wid >> 2, wc = wid & 3, fr = lane & 15, fq = lane >> 4;
    const int K = g.K, nt = K / BK;
    unsigned voffA[2], voffB[2];
#pragma unroll
    for (int i = 0; i < 2; ++i) { int R_, C; stage_rc(tid * 16 + i * 8192, R_, C); const int Rb = Epi::PERM ? ((R_ & ~31) + perm32(R_ & 31)) : R_;
        const int Ra = Epi::PERMA ? ((R_ & ~63) + 4 * (R_ & 15) + ((R_ >> 4) & 3)) : R_;
        voffA[i] = (unsigned)(Ra * K + C) * 2u; voffB[i] = (unsigned)(Rb * K + C) * 2u; }
    const size_t kstep = (size_t)(BK * 2);
    const size_t hstep = (size_t)HALF * K * 2;
    const size_t tstep = 2 * hstep;
    const unsigned ldsw = (unsigned)wid * 1024u;
    const int aoff = lds_byte(wr * 64 + fr, fq * 8), boff = lds_byte(wc * 32 + fr, fq * 8);
#define PG8_SA(b, h) (((b) * 2 + (h)) * HTB)
#define PG8_SB(b, h) ((4 + (b) * 2 + (h)) * HTB)
#define PG8_STAGE(bufoff, gbase, voff) do { _Pragma("unroll") for (int _i = 0; _i < 2; ++_i) \
        __builtin_amdgcn_global_load_lds((const unsigned*)((const char*)(gbase) + (voff)[_i]), (LAS unsigned*)(lds + (bufoff) + ldsw + _i * 8192), 16, 0, 0); } while (0)
#define PG8_LDA(dst, b, h) do { _Pragma("unroll") for (int m = 0; m < 4; ++m) _Pragma("unroll") for (int k = 0; k < 2; ++k) dst[m][k] = *(const LAS bf16x8*)(lds + PG8_SA(b, h) + aoff + m * 2048 + k * 1024); } while (0)
#define PG8_LDB(dst, b, h) do { _Pragma("unroll") for (int n = 0; n < 2; ++n) _Pragma("unroll") for (int k = 0; k < 2; ++k) dst[n][k] = *(const LAS bf16x8*)(lds + PG8_SB(b, h) + boff + n * 2048 + k * 1024); } while (0)
#define PG8_MMA(ai, bj, At, Bt) do { __builtin_amdgcn_s_setprio(1); _Pragma("unroll") for (int m = 0; m < 4; ++m) _Pragma("unroll") for (int n = 0; n < 2; ++n) _Pragma("unroll") for (int k = 0; k < 2; ++k) \
        acc[ai][bj][m][n] = __builtin_amdgcn_mfma_f32_16x16x32_bf16(Bt[n][k], At[m][k], acc[ai][bj][m][n], 0, 0, 0); __builtin_amdgcn_s_setprio(0); } while (0)
#define PG8_WAIT_V(n) asm volatile("s_waitcnt vmcnt(" #n ")" ::: "memory")
#define PG8_WAIT_L(n) asm volatile("s_waitcnt lgkmcnt(" #n ")" ::: "memory")
#define PG8_WAIT_VR(rel) do { if constexpr (Epi::EPI_VM == 16) asm volatile("s_waitcnt vmcnt(24)\n\ts_cmp_lg_u32 %0, 0\n\ts_cbranch_scc1 1\n\ts_waitcnt vmcnt(8)" :: "s"(rel) : "scc", "memory"); \
        else if constexpr (Epi::EPI_VM == 32) asm volatile("s_waitcnt vmcnt(40)\n\ts_cmp_lg_u32 %0, 0\n\ts_cbranch_scc1 1\n\ts_waitcnt vmcnt(8)" :: "s"(rel) : "scc", "memory"); \
        else asm volatile("s_waitcnt vmcnt(8)" ::: "memory"); } while (0)
#define PG8_BAR __builtin_amdgcn_s_barrier()
#define PG8_SCHED __builtin_amdgcn_sched_barrier(0)
    Unit cur, nxt; int ui = 0;
    if (!S.next(0, cur)) return;
    f32x4 acc[2][2][4][2];
#pragma unroll
    for (int a = 0; a < 2; ++a)
#pragma unroll
        for (int b = 0; b < 2; ++b)
#pragma unroll
            for (int m = 0; m < 4; ++m)
#pragma unroll
                for (int n = 0; n < 2; ++n) acc[a][b][m][n] = (f32x4){0.f, 0.f, 0.f, 0.f};
    bf16x8 At[4][2], B0[2][2], B1[2][2];
    const char* cA = (const char*)g.A + (size_t)cur.pm * tstep; const char* cB = (const char*)g.Bt + (size_t)cur.pn * tstep;
    S.a_ready(cur);
    if constexpr (SP2) {
        PG8_STAGE(PG8_SB(0, 0), cB, voffB); PG8_STAGE(PG8_SB(0, 1), cB + hstep, voffB); PG8_STAGE(PG8_SA(0, 0), cA, voffA); PG8_STAGE(PG8_SA(0, 1), cA + hstep, voffA);
        if (wr == 1) PG8_BAR;
        PG8_WAIT_V(2); PG8_BAR;
        PG8_STAGE(PG8_SB(1, 0), cB + kstep, voffB); PG8_STAGE(PG8_SA(1, 0), cA + kstep, voffA); PG8_STAGE(PG8_SB(1, 1), cB + hstep + kstep, voffB);
        PG8_WAIT_V(6); PG8_BAR;
    } else {
        PG8_STAGE(PG8_SB(0, 0), cB, voffB); PG8_STAGE(PG8_SA(0, 0), cA, voffA); PG8_STAGE(PG8_SB(0, 1), cB + hstep, voffB); PG8_STAGE(PG8_SA(0, 1), cA + hstep, voffA);
        if (wr == 1) PG8_BAR;
        PG8_WAIT_V(4); PG8_BAR;
        PG8_STAGE(PG8_SB(1, 0), cB + kstep, voffB); PG8_STAGE(PG8_SA(1, 0), cA + kstep, voffA); PG8_STAGE(PG8_SB(1, 1), cB + hstep + kstep, voffB);
        PG8_WAIT_V(6); PG8_BAR;
    }
    for (;;) {
        const bool has_next = S.next(ui + 1, nxt);
        const char* nA = has_next ? (const char*)g.A + (size_t)nxt.pm * tstep : cA; const char* nB = has_next ? (const char*)g.Bt + (size_t)nxt.pn * tstep : cB;
        for (int t = 0; t < nt; t += 2) {
            const bool last = (t == nt - 2);
            const char* a1 = cA + (size_t)(t + 1) * kstep;
            const char* a2 = last ? nA : cA + (size_t)(t + 2) * kstep; const char* b2 = last ? nB : cB + (size_t)(t + 2) * kstep;
            const char* a3 = a2 + kstep; const char* b3 = b2 + kstep;
            if (last && has_next) S.a_ready(nxt);
            if constexpr (SP2) {
            const int relaxed = __builtin_amdgcn_readfirstlane((t == 0 && ui > 0) ? 1 : 0);
            PG8_LDB(B0, 0, 0); PG8_LDB(B1, 0, 1); PG8_SCHED; PG8_LDA(At, 0, 0); PG8_STAGE(PG8_SA(1, 1), a1 + hstep, voffA);
            PG8_WAIT_VR(relaxed); PG8_WAIT_L(0); PG8_BAR; PG8_MMA(0, 0, At, B0); PG8_MMA(0, 1, At, B1); PG8_BAR; PG8_SCHED;
            PG8_LDA(At, 0, 1); PG8_STAGE(PG8_SB(0, 0), b2, voffB); PG8_STAGE(PG8_SB(0, 1), b2 + hstep, voffB); PG8_STAGE(PG8_SA(0, 0), a2, voffA);
            PG8_WAIT_VR(relaxed); PG8_WAIT_L(0); PG8_BAR; PG8_MMA(1, 0, At, B0); PG8_MMA(1, 1, At, B1); PG8_BAR; PG8_SCHED;
            PG8_LDB(B0, 1, 0); PG8_LDB(B1, 1, 1); PG8_SCHED; PG8_LDA(At, 1, 0); PG8_STAGE(PG8_SA(0, 1), a2 + hstep, voffA);
            PG8_WAIT_V(8); PG8_WAIT_L(0); PG8_BAR; PG8_MMA(0, 0, At, B0); PG8_MMA(0, 1, At, B1); PG8_BAR; PG8_SCHED;
            PG8_LDA(At, 1, 1); PG8_STAGE(PG8_SB(1, 0), b3, voffB); PG8_STAGE(PG8_SB(1, 1), b3 + hstep, voffB); PG8_STAGE(PG8_SA(1, 0), a3, voffA);
            PG8_WAIT_V(8); PG8_WAIT_L(0); PG8_BAR; PG8_MMA(1, 0, At, B0); PG8_MMA(1, 1, At, B1); PG8_BAR; PG8_SCHED;
            } else {
            PG8_LDB(B0, 0, 0); PG8_SCHED; PG8_LDA(At, 0, 0); PG8_STAGE(PG8_SA(1, 1), a1 + hstep, voffA);
            PG8_WAIT_L(8); PG8_BAR; PG8_WAIT_L(0); PG8_MMA(0, 0, At, B0); PG8_BAR; PG8_SCHED;
            PG8_LDB(B1, 0, 1); PG8_STAGE(PG8_SB(0, 0), b2, voffB);
            PG8_BAR; PG8_WAIT_L(0); PG8_MMA(0, 1, At, B1); PG8_BAR;
            PG8_LDA(At, 0, 1); PG8_STAGE(PG8_SA(0, 0), a2, voffA);
            PG8_BAR; PG8_WAIT_L(0); PG8_MMA(1, 0, At, B0); PG8_BAR; PG8_SCHED;
            PG8_STAGE(PG8_SB(0, 1), b2 + hstep, voffB);
            PG8_WAIT_V(6); PG8_BAR; PG8_MMA(1, 1, At, B1); PG8_BAR;
            PG8_LDB(B0, 1, 0); PG8_SCHED; PG8_LDA(At, 1, 0); PG8_STAGE(PG8_SA(0, 1), a2 + hstep, voffA);
            PG8_WAIT_L(8); PG8_BAR; PG8_WAIT_L(0); PG8_MMA(0, 0, At, B0); PG8_BAR; PG8_SCHED;
            PG8_LDB(B1, 1, 1); PG8_STAGE(PG8_SB(1, 0), b3, voffB);
            PG8_BAR; PG8_WAIT_L(0); PG8_MMA(0, 1, At, B1); PG8_BAR;
            PG8_LDA(At, 1, 1); PG8_STAGE(PG8_SA(1, 0), a3, voffA);
            PG8_BAR; PG8_WAIT_L(0); PG8_MMA(1, 0, At, B0); PG8_BAR; PG8_SCHED;
            PG8_STAGE(PG8_SB(1, 1), b3 + hstep, voffB);
            PG8_WAIT_V(6); PG8_BAR; PG8_MMA(1, 1, At, B1); PG8_BAR;
            }
        }
        if constexpr (ALIGN_EPI) { if (wr == 0) PG8_BAR; }
        E(acc, cur, wr, wc, fr, fq); S.done(cur);
        if (!has_next) break;
#pragma unroll
        for (int a = 0; a < 2; ++a)
#pragma unroll
            for (int b = 0; b < 2; ++b)
#pragma unroll
                for (int m = 0; m < 4; ++m)
#pragma unroll
                    for (int n = 0; n < 2; ++n) acc[a][b][m][n] = (f32x4){0.f, 0.f, 0.f, 0.f};
        cur = nxt; cA = nA; cB = nB; ++ui;
        if constexpr (ALIGN_EPI) { if (wr == 1) PG8_BAR; }
    }
    PG8_WAIT_V(0);
    if constexpr (!ALIGN_EPI) { if (wr == 0) PG8_BAR; }
    PG8_BAR;
#undef PG8_SA
#undef PG8_SB
#undef PG8_STAGE
#undef PG8_LDA
#undef PG8_LDB
#undef PG8_MMA
#undef PG8_WAIT_V
#undef PG8_WAIT_VR
#undef PG8_WAIT_L
#undef PG8_BAR
#undef PG8_SCHED
}


struct EpiZ {
    static constexpr bool PERM = true, AFTER_DRAIN = false, PERMA = false; static constexpr int EPI_VM = 16;
    bf16_t* Z; const float* ssq; LAS float* rl; mutable int last_pm;
    __device__ __forceinline__ void operator()(const f32x4 (&acc)[2][2][4][2], const Unit& u, int wr, int wc, int fr, int fq) const {
        const int row0 = u.pm * BM + wr * 64 + fr, col0 = u.pn * BM + wc * 32 + 8 * fq;
        if (u.pm != last_pm) { row_rstd_to_lds(ssq, u.pm, rl); last_pm = u.pm; }
#pragma unroll
        for (int ai = 0; ai < 2; ++ai)
#pragma unroll
            for (int m = 0; m < 4; ++m) {
                const int r = row0 + ai * HALF + m * 16; const float rs = rl[ai * HALF + wr * 64 + m * 16 + fr];
                bf16_t* rowp = Z + (size_t)r * DIN + col0;
#pragma unroll
                for (int bj = 0; bj < 2; ++bj) { const f32x4 v0 = acc[ai][bj][m][0] * rs, v1 = acc[ai][bj][m][1] * rs;
                    u32x4 w; w.x = cvt_pk_bf16(v0[0], v0[1]); w.y = cvt_pk_bf16(v0[2], v0[3]); w.z = cvt_pk_bf16(v1[0], v1[1]); w.w = cvt_pk_bf16(v1[2], v1[3]);
                    *(u32x4*)(rowp + bj * HALF) = w; } }
    }
};

struct EpiRes {
    static constexpr bool PERM = true, AFTER_DRAIN = false, PERMA = false; static constexpr int EPI_VM = 32;
    bf16_t* XB; float* ssq; float* xout;
    __device__ __forceinline__ void operator()(const f32x4 (&acc)[2][2][4][2], const Unit& u, int wr, int wc, int fr, int fq) const {
        const int lrow0 = wr * 64 + fr, col0 = u.pn * BM + wc * 32 + 8 * fq;
        const size_t o0 = ((size_t)u.pm * BM + lrow0) * D + col0;
#pragma unroll
        for (int ai = 0; ai < 2; ++ai) {
        u32x4 xin[4][2];
#pragma unroll
        for (int m = 0; m < 4; ++m)
#pragma unroll
            for (int bj = 0; bj < 2; ++bj) xin[m][bj] = *(const u32x4*)(XB + o0 + (size_t)(ai * HALF + m * 16) * D + bj * HALF);
        asm volatile("" ::: "memory");
#pragma unroll
            for (int m = 0; m < 4; ++m) {
                const size_t ro = o0 + (size_t)(ai * HALF + m * 16) * D;
                float q = 0.f;
#pragma unroll
                for (int bj = 0; bj < 2; ++bj) {
                    const u32x4 xv = xin[m][bj];
                    const f32x4 x0 = (f32x4){bf_lo(xv.x), bf_hi(xv.x), bf_lo(xv.y), bf_hi(xv.y)} + acc[ai][bj][m][0];
                    const f32x4 x1 = (f32x4){bf_lo(xv.z), bf_hi(xv.z), bf_lo(xv.w), bf_hi(xv.w)} + acc[ai][bj][m][1];
                    q += ((x0[0] * x0[0] + x0[1] * x0[1]) + (x0[2] * x0[2] + x0[3] * x0[3])) + ((x1[0] * x1[0] + x1[1] * x1[1]) + (x1[2] * x1[2] + x1[3] * x1[3]));
                    if (xout) { *(f32x4*)(xout + ro + bj * HALF) = x0; *(f32x4*)(xout + ro + bj * HALF + 4) = x1; }
                    else { u32x4 w; w.x = cvt_pk_bf16(x0[0], x0[1]); w.y = cvt_pk_bf16(x0[2], x0[3]); w.z = cvt_pk_bf16(x1[0], x1[1]); w.w = cvt_pk_bf16(x1[2], x1[3]); *(u32x4*)(XB + ro + bj * HALF) = w; }
                }
                q += __shfl_xor(q, 16); q += __shfl_xor(q, 32);
                if (fq == 0) ssq[((size_t)u.pm * BM + lrow0 + ai * HALF + m * 16) * 16 + u.pn * 4 + wc] = q;
            }
        }
    }
};

struct EpiAct {
    static constexpr bool PERM = true, AFTER_DRAIN = false, PERMA = true; static constexpr int EPI_VM = 32;
    bf16_t* ACT; const float* ssq; float* halo; const float* wf; const float* bfc; LAS float* rl; mutable int last_pm;
    static __device__ __forceinline__ f32x4 shr1(const f32x4 v) { f32x4 r;
#pragma unroll
        for (int e = 0; e < 4; ++e) r[e] = __int_as_float(__builtin_amdgcn_update_dpp(0, __float_as_int(v[e]), 0x111, 0xf, 0xf, true));
        return r; }
    __device__ __forceinline__ void operator()(const f32x4 (&acc)[2][2][4][2], const Unit& u, int wr, int wc, int fr, int fq) const {
        const int cg0 = u.pn * 128 + wc * 32 + 8 * fq;
        if (u.pm != last_pm) { row_rstd_to_lds(ssq, u.pm, rl); last_pm = u.pm; }
        u32x2 keep[2][4];
#pragma unroll
        for (int n = 0; n < 2; ++n) {
            f32x4 w0[2], w1[2], w2[2], bb[2];
#pragma unroll
            for (int bj = 0; bj < 2; ++bj) { const int col = bj * DFF + cg0 + 4 * n;
                w0[bj] = *(const f32x4*)(wf + col); w1[bj] = *(const f32x4*)(wf + DUP + col); w2[bj] = *(const f32x4*)(wf + 2 * DUP + col); bb[bj] = *(const f32x4*)(bfc + col); }
#pragma unroll
            for (int ai = 0; ai < 2; ++ai) {
                const int lrow0 = ai * HALF + wr * 64 + 4 * fr; const int rseg = u.pm * BM + ai * HALF + wr * 64; const int seg = rseg >> 6;
                const f32x4 rs = *(const LAS f32x4*)(rl + lrow0);
                f32x4 og[4];
#pragma unroll
                for (int bj = 0; bj < 2; ++bj) {
                    f32x4 c[4];
#pragma unroll
                    for (int m = 0; m < 4; ++m) c[m] = acc[ai][bj][m][n] * rs[m];
                    if (fr == 0 || fr == 15) {
                        float* hp = halo + ((size_t)seg * 4 + (fr == 0 ? 0 : 2)) * DUP + bj * DFF + cg0 + 4 * n;
                        *(f32x4*)hp = (fr == 0) ? c[0] : c[2]; *(f32x4*)(hp + DUP) = (fr == 0) ? c[1] : c[3];
                    }
                    const f32x4 s2 = shr1(c[2]), s3 = shr1(c[3]);
                    const f32x4 o0 = bb[bj] + w0[bj] * s2 + w1[bj] * s3 + w2[bj] * c[0];
                    const f32x4 o1 = bb[bj] + w0[bj] * s3 + w1[bj] * c[0] + w2[bj] * c[1];
                    const f32x4 o2 = bb[bj] + w0[bj] * c[0] + w1[bj] * c[1] + w2[bj] * c[2];
                    const f32x4 o3 = bb[bj] + w0[bj] * c[1] + w1[bj] * c[2] + w2[bj] * c[3];
                    if (bj == 0) { og[0] = o0; og[1] = o1; og[2] = o2; og[3] = o3; }
                    else {
                        const f32x4 ov[4] = {o0, o1, o2, o3};
#pragma unroll
                        for (int m = 0; m < 4; ++m) {
                            f32x4 a0;
#pragma unroll
                            for (int e = 0; e < 4; ++e) { const float g0 = og[m][e]; a0[e] = g0 * ov[m][e] * __builtin_amdgcn_rcpf(1.0f + __builtin_amdgcn_exp2f(-1.4426950408889634f * g0)); }
                            u32x2 w; w.x = cvt_pk_bf16(a0[0], a0[1]); w.y = cvt_pk_bf16(a0[2], a0[3]);
                            if (n == 0) keep[ai][m] = w;
                            else if (!(fr == 0 && m < 2)) { u32x4 w4; w4.x = keep[ai][m].x; w4.y = keep[ai][m].y; w4.z = w.x; w4.w = w.y;
                                *(u32x4*)(ACT + (size_t)(rseg + 4 * fr + m) * DFF + cg0) = w4; }
                        }
                    }
                }
            }
        }
    }
};
}

struct Params { const float* in[19]; float* out; unsigned char* ws; };
typedef const Params __attribute__((address_space(4)))* KP;
__device__ __forceinline__ Params load_params(KP k) { Params p;
#pragma unroll
    for (int i = 0; i < 19; ++i) p.in[i] = k->in[i];
    p.out = k->out; p.ws = k->ws; return p; }
__device__ __forceinline__ KP kparams() { KP k = (KP)__builtin_amdgcn_kernarg_segment_ptr(); asm volatile("" : "+s"(k)); return k; }

__device__ __forceinline__ void transpose_item(const float* W, int K, int N, bf16_t* WT, int k0, int n0, int drow0, LAS float* scr, int lane, const float* gk) {
    float wv[32];
#pragma unroll
    for (int i = 0; i < 32; ++i) { const int kk = 2 * i + (lane >> 5); wv[i] = W[(size_t)(k0 + kk) * N + n0 + (lane & 31)]; }
#pragma unroll
    for (int i = 0; i < 32; ++i) { const int kk = 2 * i + (lane >> 5); const float gg = gk ? gk[k0 + kk] : 1.0f; scr[kk * 33 + (lane & 31)] = wv[i] * gg; }
    asm volatile("s_waitcnt lgkmcnt(0)" ::: "memory");
    const int c = lane & 7;
#pragma unroll
    for (int j = 0; j < 4; ++j) { const int n = (lane >> 3) + 8 * j; const LAS float* s = scr + (8 * c) * 33 + n;
        u32x4 o; o.x = cvt_pk_bf16(s[0 * 33], s[1 * 33]); o.y = cvt_pk_bf16(s[2 * 33], s[3 * 33]); o.z = cvt_pk_bf16(s[4 * 33], s[5 * 33]); o.w = cvt_pk_bf16(s[6 * 33], s[7 * 33]);
        *(u32x4*)(WT + (size_t)(drow0 + n) * K + k0 + 8 * c) = o; }
    asm volatile("s_waitcnt lgkmcnt(0)" ::: "memory");
}

__device__ __forceinline__ void prologue(LAS unsigned char* lds, KP pk) {
    const Params p = load_params(pk);
    const int tid = threadIdx.x, lane = tid & 63, wave = tid >> 6;
    const int gw = blockIdx.x * 8 + wave, NGW = gridDim.x * 8;
    LAS float* scr = (LAS float*)(lds + wave * 16384);
    unsigned char* ws = p.ws;
    constexpr int I_IN = (D / 64) * (DIN / 32), I_OUT = (D / 64) * (D / 32), I_UP = (D / 64) * (DUP / 32), I_DN = (DFF / 64) * (D / 32), I_L = I_IN + I_OUT + I_UP + I_DN;
    for (int it = gw; it < NLAYER * I_L; it += NGW) {
        const int l = it / I_L; int r = it % I_L;
        if (r < I_IN) { const int nblk = DIN / 32, kb = r / nblk, nb = r % nblk; transpose_item(p.in[6] + (size_t)l * D * DIN, D, DIN, (bf16_t*)(ws + WS_WIN) + (size_t)l * DIN * D, 64 * kb, 32 * nb, 32 * nb, scr, lane, p.in[5] + (size_t)l * D); continue; } r -= I_IN;
        if (r < I_OUT) { const int nblk = D / 32, kb = r / nblk, nb = r % nblk; transpose_item(p.in[12] + (size_t)l * D * D, D, D, (bf16_t*)(ws + WS_WOUT) + (size_t)l * D * D, 64 * kb, 32 * nb, 32 * nb, scr, lane, nullptr); continue; } r -= I_OUT;
        if (r < I_UP) { const int nblk = DUP / 32, kb = r / nblk, nb = r % nblk; const int n0 = 32 * nb;
            const int drow = (n0 < DFF) ? (n0 / 128) * 256 + (n0 % 128) : ((n0 - DFF) / 128) * 256 + 128 + ((n0 - DFF) % 128);
            transpose_item(p.in[14] + (size_t)l * D * DUP, D, DUP, (bf16_t*)(ws + WS_WUP) + (size_t)l * DUP * D, 64 * kb, n0, drow, scr, lane, p.in[13] + (size_t)l * D); continue; } r -= I_UP;
        { const int nblk = D / 32, kb = r / nblk, nb = r % nblk; transpose_item(p.in[17] + (size_t)l * DFF * D, DFF, D, (bf16_t*)(ws + WS_WDN) + (size_t)l * D * DFF, 64 * kb, 32 * nb, 32 * nb, scr, lane, nullptr); }
    }
    { bf16_t* wsb = (bf16_t*)(ws + WS_WSB); const float* wsrc = p.in[7];
      for (int i = (blockIdx.x * 512 + tid) * 2; i < NLAYER * 4 * 128 * 128; i += gridDim.x * 512 * 2) { const int k = i & 127, q = (i >> 7) & 127;
          const f32x2 v = *(const f32x2*)(wsrc + i); *(unsigned*)(wsb + i) = cvt_pk_bf16(k <= q ? v.x : 0.f, k + 1 <= q ? v.y : 0.f); } }
    { bf16_t* wpt = (bf16_t*)(ws + WS_WPT); const float* wp = p.in[9];
      for (int i = blockIdx.x * 512 + tid; i < NLAYER * 4 * 64 * 64; i += gridDim.x * 512) { const int c = i & 63, dd = (i >> 6) & 63, lg = i >> 12;
          wpt[i] = (bf16_t)(cvt_pk_bf16(wp[(size_t)lg * 4096 + c * 64 + dd], 0.f) & 0xffffu); } }
    { bf16_t* XB = (bf16_t*)(ws + WS_XB); float* ssq = (float*)(ws + WS_SSQ);
      for (int rb = gw; rb < R; rb += 4 * NGW) {
          f32x4 v[4][4];
#pragma unroll
          for (int i = 0; i < 4; ++i) { const int r = rb + i * NGW; if (r < R) { const float* xr = (r < RP) ? p.in[0] + (size_t)r * D : p.in[1] + (size_t)(r - RP) * D;
#pragma unroll
              for (int j = 0; j < 2; ++j) { v[i][2 * j] = *(const f32x4*)(xr + 512 * j + 8 * lane); v[i][2 * j + 1] = *(const f32x4*)(xr + 512 * j + 8 * lane + 4); } } }
#pragma unroll
          for (int i = 0; i < 4; ++i) { const int r = rb + i * NGW; if (r < R) { float s = 0.f;
#pragma unroll
              for (int j = 0; j < 2; ++j) { const f32x4 a = v[i][2 * j], c = v[i][2 * j + 1];
                  s += ((a.x * a.x + a.y * a.y) + (a.z * a.z + a.w * a.w)) + ((c.x * c.x + c.y * c.y) + (c.z * c.z + c.w * c.w));
                  u32x4 w; w.x = cvt_pk_bf16(a.x, a.y); w.y = cvt_pk_bf16(a.z, a.w); w.z = cvt_pk_bf16(c.x, c.y); w.w = cvt_pk_bf16(c.z, c.w); *(u32x4*)(XB + (size_t)r * D + 512 * j + 8 * lane) = w; }
              s = wave_sum(s);
              if (lane < 16) ssq[(size_t)r * 16 + lane] = (lane == 0) ? s : 0.f; } }
      } }
}

__device__ __forceinline__ void mixer_phase(LAS unsigned char* lds, KP pk, int l) {
    const Params p = load_params(pk);
    int tid = threadIdx.x; asm volatile("" : "+v"(tid));
    const int lane = tid & 63, w8 = __builtin_amdgcn_readfirstlane(tid >> 6), fr = lane & 15, fq = lane >> 4;
    unsigned char* ws = p.ws;
    const bf16_t* Z = (const bf16_t*)(ws + WS_Z); bf16_t* Y = (bf16_t*)(ws + WS_Y);
    const bf16_t* WPT = (const bf16_t*)(ws + WS_WPT) + (size_t)l * 4 * 64 * 64;
    const bf16_t* WSB = (const bf16_t*)(ws + WS_WSB) + (size_t)l * 4 * 128 * 128; const float* b_s = p.in[8] + (size_t)l * 4 * 128;
    const float* pscale = p.in[10] + (size_t)l * 256; const float* wcv = p.in[11] + (size_t)l * 3 * 256;
    float* out = p.out;
    LAS bf16_t* PB = (LAS bf16_t*)lds;
    LAS bf16_t* DM = (LAS bf16_t*)(lds + 143 * 512);
    LAS bf16_t* VT = (LAS bf16_t*)lds;
#pragma unroll 1
    for (int item = blockIdx.x; item < 256 + 40; item += gridDim.x) {
        const bool smp = item >= 256;
        const int L = smp ? 32 : 128;
        const int st = item - 256;
        const int b = smp ? (st < 32 ? st >> 2 : st - 32) : item >> 7;
        const int h0 = smp ? (st < 32 ? (st & 3) : 0) : 0, h1 = smp ? (st < 32 ? h0 + 1 : 0) : 4;
        const bool doBC = !smp || st >= 32;
        const int t0 = smp ? 0 : (item & 127) * 128;
        const int r0 = smp ? RP + 32 * b : item * 128;
        const bool fresh = smp || t0 == 0;
        const bool lastc = smp || (item & 127) == 127;
        const int pos0 = smp ? 4096 : t0;
        const float* st_pool = p.in[2] + ((size_t)l * NBS + b) * 15 * 256;
        const float* st_conv = p.in[3] + ((size_t)l * NBS + b) * 2 * 256;
        __syncthreads();
        if (doBC) {
        {
            const int npair = (L + 16) >> 1;
            for (int pi = (fresh ? 8 : 0) + w8; pi < npair; pi += 8) {
                const bf16_t* srcp = Z + (size_t)(r0 + 2 * pi - 15 + (lane >> 5)) * DIN + 1024 + (lane & 31) * 8;
                __builtin_amdgcn_global_load_lds((const unsigned*)srcp, (LAS unsigned*)(PB + pi * 512), 16, 0, 0);
            }
        }
#pragma unroll 1
        for (int half = 0; half < 2; ++half) {
            const int c8 = (tid & 31) * 8, RPB = L >> 5, ts = (tid >> 5) * 2 * RPB + half * RPB;
            u32x4 gcr[6], hcr[6], gbr[4];
            {
                const bf16_t* zb = Z + (size_t)(r0 + ts - 2) * DIN + c8;
#pragma unroll
                for (int i = 0; i < 6; ++i) if (i < RPB + 2 && (ts + i - 2 >= 0 || !fresh)) { gcr[i] = *(const u32x4*)(zb + (size_t)i * DIN + 1536); hcr[i] = *(const u32x4*)(zb + (size_t)i * DIN + 1792); }
#pragma unroll
                for (int i = 0; i < 4; ++i) if (i < RPB) gbr[i] = *(const u32x4*)(zb + (size_t)(i + 2) * DIN + 1280);
            }
            const f32x4 wa0 = *(const f32x4*)(wcv + c8), wb0 = *(const f32x4*)(wcv + c8 + 4), wa1 = *(const f32x4*)(wcv + 256 + c8), wb1 = *(const f32x4*)(wcv + 256 + c8 + 4), wa2 = *(const f32x4*)(wcv + 512 + c8), wb2 = *(const f32x4*)(wcv + 512 + c8 + 4);
            asm volatile("" ::: "memory");
            float q2[8], q1[8];
#pragma unroll
            for (int i = 0; i < 2; ++i) { const int tt = ts + i - 2; float qq[8];
                if (tt >= 0 || !fresh) {
#pragma unroll
                    for (int e = 0; e < 4; ++e) { qq[2 * e] = bf_lo(gcr[i][e]) * bf_lo(hcr[i][e]); qq[2 * e + 1] = bf_hi(gcr[i][e]) * bf_hi(hcr[i][e]); } }
                else if (smp) { const f32x4 a = *(const f32x4*)(st_conv + (2 + tt) * 256 + c8), bq = *(const f32x4*)(st_conv + (2 + tt) * 256 + c8 + 4);
#pragma unroll
                    for (int e = 0; e < 4; ++e) { qq[e] = a[e]; qq[4 + e] = bq[e]; } }
                else {
#pragma unroll
                    for (int e = 0; e < 8; ++e) qq[e] = 0.f; }
#pragma unroll
                for (int e = 0; e < 8; ++e) { if (i == 0) q2[e] = qq[e]; else q1[e] = qq[e]; } }
            bf16_t* yb = Y + (size_t)(r0 + ts) * D + 768 + c8;
#pragma unroll
            for (int i = 0; i < 4; ++i) if (i < RPB) {
                const int t = ts + i; const u32x4 gc = gcr[i + 2], hc = hcr[i + 2], gb = gbr[i];
                float q0[8], yv[8];
#pragma unroll
                for (int e = 0; e < 4; ++e) { q0[2 * e] = bf_lo(gc[e]) * bf_lo(hc[e]); q0[2 * e + 1] = bf_hi(gc[e]) * bf_hi(hc[e]); }
#pragma unroll
                for (int e = 0; e < 8; ++e) { const float w0 = (e < 4) ? wa0[e & 3] : wb0[e & 3], w1 = (e < 4) ? wa1[e & 3] : wb1[e & 3], w2 = (e < 4) ? wa2[e & 3] : wb2[e & 3];
                    const float cv = w0 * q2[e] + w1 * q1[e] + w2 * q0[e];
                    const float g = (e & 1) ? bf_hi(gb[e >> 1]) : bf_lo(gb[e >> 1]); yv[e] = g * cv; }
                u32x4 w; w.x = cvt_pk_bf16(yv[0], yv[1]); w.y = cvt_pk_bf16(yv[2], yv[3]); w.z = cvt_pk_bf16(yv[4], yv[5]); w.w = cvt_pk_bf16(yv[6], yv[7]);
                *(u32x4*)(yb + (size_t)i * D) = w;
                if (lastc && t >= L - 2) { float* o = out + (smp ? O_CONVS + ((size_t)l * NBS + b) * 512 : O_CONVP + ((size_t)l * NBP + b) * 512) + (t - (L - 2)) * 256 + c8;
                    *(f32x4*)o = (f32x4){q0[0], q0[1], q0[2], q0[3]}; *(f32x4*)(o + 4) = (f32x4){q0[4], q0[5], q0[6], q0[7]}; }
#pragma unroll
                for (int e = 0; e < 8; ++e) { q2[e] = q1[e]; q1[e] = q0[e]; }
            }
            asm volatile("" ::: "memory");
        }
        if (smp) for (int it = tid; it < 32 * 64; it += 512) { const int t = it >> 6, c8 = (it & 63) * 8; const u32x4 v = *(const u32x4*)(Z + (size_t)(r0 + t) * DIN + 512 + c8);
            float* o = out + O_VS + (((size_t)l * NBS + b) * 32 + t) * 512 + c8;
            *(f32x4*)o = (f32x4){bf_lo(v.x), bf_hi(v.x), bf_lo(v.y), bf_hi(v.y)}; *(f32x4*)(o + 4) = (f32x4){bf_lo(v.z), bf_hi(v.z), bf_lo(v.w), bf_hi(v.w)}; }
        if (fresh) { const int j = tid >> 5, c8 = (tid & 31) * 8; u32x4 v;
            if (j == 15) v = *(const u32x4*)(Z + (size_t)r0 * DIN + 1024 + c8);
            else if (smp) { const f32x4 a = *(const f32x4*)(st_pool + j * 256 + c8), bq = *(const f32x4*)(st_pool + j * 256 + c8 + 4);
                v.x = cvt_pk_bf16(a.x, a.y); v.y = cvt_pk_bf16(a.z, a.w); v.z = cvt_pk_bf16(bq.x, bq.y); v.w = cvt_pk_bf16(bq.z, bq.w); }
            else v = (u32x4){0u, 0u, 0u, 0u};
            *(LAS u32x4*)(PB + j * 256 + c8) = v; }
        asm volatile("s_waitcnt vmcnt(0)" ::: "memory");
        __syncthreads();
        if (lastc && tid < 15 * 32) {
            const int i15 = tid >> 5, c8 = (tid & 31) * 8; const u32x4 v = *(const LAS u32x4*)(PB + (L + i15) * 256 + c8);
            float* o = out + (smp ? O_POOLS + ((size_t)l * NBS + b) * 15 * 256 : O_POOLP + ((size_t)l * NBP + b) * 15 * 256) + i15 * 256 + c8;
            *(f32x4*)o = (f32x4){bf_lo(v.x), bf_hi(v.x), bf_lo(v.y), bf_hi(v.y)}; *(f32x4*)(o + 4) = (f32x4){bf_lo(v.z), bf_hi(v.z), bf_lo(v.w), bf_hi(v.w)}; }
        {
            const int cp = tid & 127, rq = tid >> 7;
            if (rq * 32 < L) {
                const int w = 2 << (cp >> 5);
                const LAS unsigned* pcol = (const LAS unsigned*)PB + cp;
                const int ts = rq * 32;
                float s0 = 0.f, s1 = 0.f;
                for (int jj = 0; jj < w; ++jj) { const unsigned v = pcol[(15 + ts - jj) * 128]; s0 += bf_lo(v); s1 += bf_hi(v); }
#pragma unroll 4
                for (int t = ts; t < ts + 32; ++t) {
                    const unsigned v = pcol[(15 + t) * 128];
                    if (t > ts) { const unsigned vo = pcol[(15 + t - w) * 128]; s0 += bf_lo(v) - bf_lo(vo); s1 += bf_hi(v) - bf_hi(vo); }
                    const int pos = pos0 + t; const float cnt = (float)((pos + 1 < w) ? pos + 1 : w); const float ic = __builtin_amdgcn_rcpf(cnt);
                    const float d0 = s0 * ic - bf_lo(v), d1 = s1 * ic - bf_hi(v);
                    *((LAS unsigned*)(DM + t * 264) + cp) = cvt_pk_bf16(d0, d1);
                }
            }
        }
        __syncthreads();
        if (w8 * 16 < L) {
            bf16_t* yr = Y + (size_t)(r0 + 16 * w8 + fr) * D + 512;
#pragma unroll 1
            for (int g = 0; g < 4; ++g) {
                f32x4 acc[4];
#pragma unroll
                for (int dt = 0; dt < 4; ++dt) acc[dt] = (f32x4){0.f, 0.f, 0.f, 0.f};
#pragma unroll
                for (int ks = 0; ks < 2; ++ks) {
                    const bf16x8 yf = *(const LAS bf16x8*)(DM + (16 * w8 + fr) * 264 + 64 * g + 32 * ks + 8 * fq);
#pragma unroll
                    for (int dt = 0; dt < 4; ++dt) { const bf16x8 xf = *(const bf16x8*)(WPT + ((size_t)g * 64 + 16 * dt + fr) * 64 + 32 * ks + 8 * fq);
                        acc[dt] = __builtin_amdgcn_mfma_f32_16x16x32_bf16(xf, yf, acc[dt], 0, 0, 0); }
                }
#pragma unroll
                for (int dt = 0; dt < 4; ++dt) { const int col = 64 * g + 16 * dt + 4 * fq; const f32x4 sc = *(const f32x4*)(pscale + col); const f32x4 v = acc[dt] * sc;
                    u32x2 w; w.x = cvt_pk_bf16(v[0], v[1]); w.y = cvt_pk_bf16(v[2], v[3]); *(u32x2*)(yr + col) = w; }
            }
        }
        }
        asm volatile("" ::: "memory");
#pragma unroll 1
        for (int h = h0; h < h1; ++h) {
            const bool actw = (w8 * 16 < L);
            const int sl = (L == 128 && (h & 1)) ? 7 - w8 : w8;
            const int q = 16 * sl + fr, nks = sl / 2 + 1;
            const int nvi = (L == 128) ? 4 : 1;
            const int vk = (L == 128) ? 16 * w8 + (lane & 15) : 16 * (w8 & 1) + (lane & 15);
            u32x4 vreg[4];
#pragma unroll
            for (int i = 0; i < 4; ++i) if (i < nvi) { const int d8 = 8 * (4 * ((L == 128) ? i : (w8 >> 1)) + (lane >> 4));
                vreg[i] = *(const u32x4*)(Z + (size_t)(r0 + vk) * DIN + 512 + 128 * h + d8); }
            bf16x8 wfr[4]; u32x4 uu[4]; float bs = 0.f;
            if (actw) {
#pragma unroll
                for (int ks = 0; ks < 4; ++ks) if (ks < nks) wfr[ks] = *(const bf16x8*)(WSB + ((size_t)h * 128 + q) * 128 + 32 * ks + 8 * fq);
                const bf16_t* ur = Z + (size_t)(r0 + q) * DIN + 128 * h;
#pragma unroll
                for (int j = 0; j < 4; ++j) uu[j] = *(const u32x4*)(ur + 32 * j + 8 * fq);
                bs = b_s[h * 128 + q];
            }
            __syncthreads();
#pragma unroll
            for (int i = 0; i < 4; ++i) if (i < nvi) { const int d8 = 8 * (4 * ((L == 128) ? i : (w8 >> 1)) + (lane >> 4)); const u32x4 v = vreg[i];
                LAS bf16_t* o = VT + d8 * 136 + vk;
                o[0 * 136] = (bf16_t)(v.x & 0xffffu); o[1 * 136] = (bf16_t)(v.x >> 16); o[2 * 136] = (bf16_t)(v.y & 0xffffu); o[3 * 136] = (bf16_t)(v.y >> 16);
                o[4 * 136] = (bf16_t)(v.z & 0xffffu); o[5 * 136] = (bf16_t)(v.z >> 16); o[6 * 136] = (bf16_t)(v.w & 0xffffu); o[7 * 136] = (bf16_t)(v.w >> 16); }
            __syncthreads();
            if (actw) {
                f32x4 acc[8];
#pragma unroll
                for (int dt = 0; dt < 8; ++dt) acc[dt] = (f32x4){0.f, 0.f, 0.f, 0.f};
#pragma unroll
                for (int ks = 0; ks < 4; ++ks) if (ks < nks) {
                    const int k0 = 32 * ks + 8 * fq;
                    const bf16x8 wf = wfr[ks];
#pragma unroll
                    for (int dt = 0; dt < 8; ++dt) { const bf16x8 vf = *(const LAS bf16x8*)(VT + (32 * (dt >> 1) + 8 * (fr >> 2) + 4 * (dt & 1) + (fr & 3)) * 136 + k0);
                        acc[dt] = __builtin_amdgcn_mfma_f32_16x16x32_bf16(vf, wf, acc[dt], 0, 0, 0); }
                }
                bf16_t* yr = Y + (size_t)(r0 + q) * D + 128 * h;
#pragma unroll
                for (int j = 0; j < 4; ++j) { const u32x4 u4 = uu[j]; const f32x4 a0 = acc[2 * j], a1 = acc[2 * j + 1];
                    u32x4 w;
                    w.x = cvt_pk_bf16(bf_lo(u4.x) * (a0[0] + bs), bf_hi(u4.x) * (a0[1] + bs)); w.y = cvt_pk_bf16(bf_lo(u4.y) * (a0[2] + bs), bf_hi(u4.y) * (a0[3] + bs));
                    w.z = cvt_pk_bf16(bf_lo(u4.z) * (a1[0] + bs), bf_hi(u4.z) * (a1[1] + bs)); w.w = cvt_pk_bf16(bf_lo(u4.w) * (a1[2] + bs), bf_hi(u4.w) * (a1[3] + bs));
                    *(u32x4*)(yr + 32 * j + 8 * fq) = w; }
            }
        }
    }
    __syncthreads();
}

template <int NB, int NM, int U>
__device__ __forceinline__ void thin_kloop(f32x4 (&acc)[NB][NM], const bf16_t* (&wp)[NB], const bf16_t* (&ap)[NM], int kbeg, int kend) {
#pragma unroll 1
    for (int k = kbeg; k < kend; k += 32 * U) {
        bf16x8 wf[U][NB], af[U][NM];
#pragma unroll
        for (int u = 0; u < U; ++u) if (k + 32 * u < kend) {
#pragma unroll
            for (int nb = 0; nb < NB; ++nb) wf[u][nb] = *(const bf16x8*)(wp[nb] + k + 32 * u);
#pragma unroll
            for (int nm = 0; nm < NM; ++nm) af[u][nm] = *(const bf16x8*)(ap[nm] + k + 32 * u);
        }
        __builtin_amdgcn_sched_barrier(0);
#pragma unroll
        for (int u = 0; u < U; ++u) if (k + 32 * u < kend) {
#pragma unroll
            for (int nb = 0; nb < NB; ++nb)
#pragma unroll
                for (int nm = 0; nm < NM; ++nm) acc[nb][nm] = __builtin_amdgcn_mfma_f32_16x16x32_bf16(wf[u][nb], af[u][nm], acc[nb][nm], 0, 0, 0);
        }
        __builtin_amdgcn_sched_barrier(0);
    }
}
__device__ __forceinline__ void thin_z(LAS unsigned char* lds, const bf16_t* XB, const bf16_t* Wt, const float* ssq, bf16_t* Z) {
    if (blockIdx.x >= 256) return;
    int tid = threadIdx.x; asm volatile("" : "+v"(tid));
    const int lane = tid & 63, w = __builtin_amdgcn_readfirstlane(tid >> 6), fr = lane & 15, fq = lane >> 4;
    const int b = blockIdx.x >> 5, cgp = blockIdx.x & 31, r0 = RP + 32 * b, nm = w >> 2;
    const float rs = rstd_of(ssq + (size_t)(r0 + 16 * nm + fr) * 16);
    f32x4 acc[4][2];
    const bf16_t* wp[4];
#pragma unroll
    for (int nb = 0; nb < 4; ++nb) { acc[nb][0] = (f32x4){0.f, 0.f, 0.f, 0.f}; acc[nb][1] = (f32x4){0.f, 0.f, 0.f, 0.f}; wp[nb] = Wt + (size_t)(16 * (cgp * 4 + nb) + fr) * D + 8 * fq; }
    const bf16_t* ap[2] = {XB + (size_t)(r0 + fr) * D + 8 * fq, XB + (size_t)(r0 + 16 + fr) * D + 8 * fq};
    thin_kloop<4, 2, 4>(acc, wp, ap, w * (D / 8), (w + 1) * (D / 8));
    LAS f32x4* red = (LAS f32x4*)lds;
#pragma unroll
    for (int nb = 0; nb < 4; ++nb)
#pragma unroll
        for (int m2 = 0; m2 < 2; ++m2) red[(w * 8 + nb * 2 + m2) * 64 + lane] = acc[nb][m2];
    __syncthreads();
    f32x4 s = (f32x4){0.f, 0.f, 0.f, 0.f};
#pragma unroll
    for (int sw = 0; sw < 8; ++sw) s += red[(sw * 8 + (w & 3) * 2 + nm) * 64 + lane];
    const f32x4 v = s * rs;
    u32x2 o; o.x = cvt_pk_bf16(v[0], v[1]); o.y = cvt_pk_bf16(v[2], v[3]);
    *(u32x2*)(Z + (size_t)(r0 + 16 * nm + fr) * DIN + 16 * (cgp * 4 + (w & 3)) + 4 * fq) = o;
    __syncthreads();
}
__device__ __forceinline__ void thin_res(LAS unsigned char* lds, const bf16_t* A, const bf16_t* Wt, int K, bf16_t* XB, float* ssq, float* xout) {
    if (blockIdx.x >= 128) return;
    int tid = threadIdx.x; asm volatile("" : "+v"(tid));
    const int lane = tid & 63, w = __builtin_amdgcn_readfirstlane(tid >> 6), fr = lane & 15, fq = lane >> 4;
    const int b = blockIdx.x >> 4, cgp = blockIdx.x & 15, r0 = RP + 32 * b, cb = cgp * 4 + (w & 3), nm = w >> 2;
    const int col = 16 * cb + 4 * fq; const size_t r = (size_t)r0 + 16 * nm + fr;
    const u32x2 xv = *(const u32x2*)(XB + r * D + col);
    f32x4 acc[4][2];
    const bf16_t* wp[4];
#pragma unroll
    for (int nb = 0; nb < 4; ++nb) { acc[nb][0] = (f32x4){0.f, 0.f, 0.f, 0.f}; acc[nb][1] = (f32x4){0.f, 0.f, 0.f, 0.f}; wp[nb] = Wt + (size_t)(16 * (cgp * 4 + nb) + fr) * K + 8 * fq; }
    const bf16_t* ap[2] = {A + (size_t)(r0 + fr) * K + 8 * fq, A + (size_t)(r0 + 16 + fr) * K + 8 * fq};
    const int kslice = K / 8;
    thin_kloop<4, 2, 4>(acc, wp, ap, w * kslice, (w + 1) * kslice);
    LAS f32x4* red = (LAS f32x4*)lds;
#pragma unroll
    for (int nb = 0; nb < 4; ++nb)
#pragma unroll
        for (int m2 = 0; m2 < 2; ++m2) red[(w * 8 + nb * 2 + m2) * 64 + lane] = acc[nb][m2];
    __syncthreads();
    f32x4 s = (f32x4){0.f, 0.f, 0.f, 0.f};
#pragma unroll
    for (int sw = 0; sw < 8; ++sw) s += red[(sw * 8 + (w & 3) * 2 + nm) * 64 + lane];
    const f32x4 x = (f32x4){bf_lo(xv.x), bf_hi(xv.x), bf_lo(xv.y), bf_hi(xv.y)} + s;
    if (xout) *(f32x4*)(xout + r * D + col) = x;
    else { u32x2 o; o.x = cvt_pk_bf16(x[0], x[1]); o.y = cvt_pk_bf16(x[2], x[3]); *(u32x2*)(XB + r * D + col) = o; }
    float q = (x[0] * x[0] + x[1] * x[1]) + (x[2] * x[2] + x[3] * x[3]);
    q += __shfl_xor(q, 16); q += __shfl_xor(q, 32);
    LAS float* part = (LAS float*)(lds + pg8::STAGE_BYTES + 2048);
    if (fq == 0) part[w * 16 + fr] = q;
    __syncthreads();
    if (tid < 32) { const int m2 = tid >> 4, f2 = tid & 15; const float sq = (part[(m2 * 4 + 0) * 16 + f2] + part[(m2 * 4 + 1) * 16 + f2]) + (part[(m2 * 4 + 2) * 16 + f2] + part[(m2 * 4 + 3) * 16 + f2]);
        ssq[((size_t)r0 + tid) * 16 + cgp] = sq; }
    __syncthreads();
}
__device__ __forceinline__ void thin_act(const bf16_t* XB, const bf16_t* Wt, const float* ssq, bf16_t* ACT, const float* wf, const float* bfc, const float* st_ffn_l, float* out_ffns_l) {
    if (blockIdx.x >= 256) return;
    int tid = threadIdx.x; asm volatile("" : "+v"(tid));
    const int lane = tid & 63, w = __builtin_amdgcn_readfirstlane(tid >> 6), fr = lane & 15, fq = lane >> 4;
    const int b = blockIdx.x >> 5, cgp = (blockIdx.x >> 1) & 15, half = blockIdx.x & 1, r0 = RP + 32 * b;
    const int j = half * 6 + w;
    if (w < 6 && j < 11) {
        const int P = cgp * 11 + j, cg = 16 * P;
        const int wrow = (cg >> 7) * 256 + (cg & 127);
        const int c4 = cg + 4 * fq;
        const float rs0 = rstd_of(ssq + (size_t)(r0 + fr) * 16), rs1 = rstd_of(ssq + (size_t)(r0 + 16 + fr) * 16);
        f32x4 w0[2], w1[2], w2[2], bb[2], prev[2];
#pragma unroll
        for (int bj = 0; bj < 2; ++bj) { const int col = bj * DFF + c4;
            w0[bj] = *(const f32x4*)(wf + col); w1[bj] = *(const f32x4*)(wf + DUP + col); w2[bj] = *(const f32x4*)(wf + 2 * DUP + col); bb[bj] = *(const f32x4*)(bfc + col);
            prev[bj] = (fr >= 14) ? *(const f32x4*)(st_ffn_l + ((size_t)b * 2 + (fr - 14)) * DUP + col) : (f32x4){0.f, 0.f, 0.f, 0.f}; }
        f32x4 acc[2][2];
#pragma unroll
        for (int a = 0; a < 2; ++a)
#pragma unroll
            for (int c = 0; c < 2; ++c) acc[a][c] = (f32x4){0.f, 0.f, 0.f, 0.f};
        const bf16_t* wp[2] = {Wt + (size_t)(wrow + fr) * D + 8 * fq, Wt + (size_t)(wrow + 128 + fr) * D + 8 * fq};
        const bf16_t* ap[2] = {XB + (size_t)(r0 + fr) * D + 8 * fq, XB + (size_t)(r0 + 16 + fr) * D + 8 * fq};
        thin_kloop<2, 2, 8>(acc, wp, ap, 0, D);
#pragma unroll
        for (int nm = 0; nm < 2; ++nm) {
            f32x4 cur[2], o[2];
#pragma unroll
            for (int bj = 0; bj < 2; ++bj) { cur[bj] = acc[bj][nm] * (nm ? rs1 : rs0);
#pragma unroll
                for (int e = 0; e < 4; ++e) { const float c0 = cur[bj][e], p0 = prev[bj][e];
                    const float u1 = dpp_ror1(fr == 15 ? p0 : c0), u2 = dpp_ror2(fr >= 14 ? p0 : c0);
                    o[bj][e] = bb[bj][e] + w0[bj][e] * u2 + w1[bj][e] * u1 + w2[bj][e] * c0; } }
            f32x4 a0;
#pragma unroll
            for (int e = 0; e < 4; ++e) { const float g0 = o[0][e]; a0[e] = g0 * o[1][e] * __builtin_amdgcn_rcpf(1.0f + __builtin_amdgcn_exp2f(-1.4426950408889634f * g0)); }
            u32x2 ov; ov.x = cvt_pk_bf16(a0[0], a0[1]); ov.y = cvt_pk_bf16(a0[2], a0[3]);
            *(u32x2*)(ACT + (size_t)(r0 + 16 * nm + fr) * DFF + c4) = ov;
            if (nm == 1 && fr >= 14) {
#pragma unroll
                for (int bj = 0; bj < 2; ++bj) *(f32x4*)(out_ffns_l + ((size_t)b * 2 + (fr - 14)) * DUP + bj * DFF + c4) = cur[bj]; }
            prev[0] = cur[0]; prev[1] = cur[1];
        }
    }
}

__device__ __forceinline__ void fixup_phase(KP pk, int l) {
    const Params p = load_params(pk);
    int tid = threadIdx.x; asm volatile("" : "+v"(tid));
    unsigned char* ws = p.ws;
    const float* halo = (const float*)(ws + WS_HALO);
    bf16_t* ACT = (bf16_t*)(ws + WS_ACT);
    const float* wf = p.in[15] + (size_t)l * 3 * DUP; const float* bfc = p.in[16] + (size_t)l * DUP;
    float* out = p.out;
    for (int idx = blockIdx.x; idx < 1024 + 4; idx += gridDim.x) {
        if (idx < 1024) {
            const int seg = idx >> 1, j = idx & 1; const size_t row = (size_t)seg * 64 + j;
            const float* u0 = halo + (size_t)seg * 4 * DUP; const float* u1 = u0 + DUP;
            const float* um2 = ((seg & 255) == 0) ? nullptr : halo + ((size_t)(seg - 1) * 4 + 2) * DUP; const float* um1 = um2 ? um2 + DUP : nullptr;
            const float* p0 = j ? u1 : u0; const float* p1 = j ? u0 : um1; const float* p2 = j ? um1 : um2;
            for (int c8 = tid * 8; c8 < DFF; c8 += 512 * 8) {
                float gv[8], av[8];
#pragma unroll
                for (int hh = 0; hh < 2; ++hh) { const f32x4 bg = *(const f32x4*)(bfc + c8 + 4 * hh), ba = *(const f32x4*)(bfc + DFF + c8 + 4 * hh);
                    const f32x4 wg2 = *(const f32x4*)(wf + 2 * DUP + c8 + 4 * hh), wa2 = *(const f32x4*)(wf + 2 * DUP + DFF + c8 + 4 * hh);
                    const f32x4 xg = *(const f32x4*)(p0 + c8 + 4 * hh), xa = *(const f32x4*)(p0 + DFF + c8 + 4 * hh);
                    f32x4 g4 = bg + wg2 * xg, a4 = ba + wa2 * xa;
                    if (p1) { g4 += *(const f32x4*)(wf + DUP + c8 + 4 * hh) * *(const f32x4*)(p1 + c8 + 4 * hh); a4 += *(const f32x4*)(wf + DUP + DFF + c8 + 4 * hh) * *(const f32x4*)(p1 + DFF + c8 + 4 * hh); }
                    if (p2) { g4 += *(const f32x4*)(wf + c8 + 4 * hh) * *(const f32x4*)(p2 + c8 + 4 * hh); a4 += *(const f32x4*)(wf + DFF + c8 + 4 * hh) * *(const f32x4*)(p2 + DFF + c8 + 4 * hh); }
#pragma unroll
                    for (int e = 0; e < 4; ++e) { gv[4 * hh + e] = g4[e]; av[4 * hh + e] = a4[e]; } }
                float v[8];
#pragma unroll
                for (int e = 0; e < 8; ++e) v[e] = gv[e] * av[e] * __builtin_amdgcn_rcpf(1.0f + __builtin_amdgcn_exp2f(-1.4426950408889634f * gv[e]));
                u32x4 w; w.x = cvt_pk_bf16(v[0], v[1]); w.y = cvt_pk_bf16(v[2], v[3]); w.z = cvt_pk_bf16(v[4], v[5]); w.w = cvt_pk_bf16(v[6], v[7]);
                *(u32x4*)(ACT + row * DFF + c8) = w;
            }
        } else {
            const int k = idx - 1024, b = k >> 1, j = k & 1;
            const float* src = halo + ((size_t)(256 * b + 255) * 4 + 2 + j) * DUP; float* dst = out + O_FFNP + (((size_t)l * NBP + b) * 2 + j) * DUP;
            for (int c = tid * 4; c < DUP; c += 512 * 4) *(f32x4*)(dst + c) = *(const f32x4*)(src + c);
        }
    }
}

__device__ __forceinline__ void final_phase(KP pk) {
    const Params p = load_params(pk);
    const int tid = threadIdx.x, lane = tid & 63, wave = tid >> 6;
    const int gw = blockIdx.x * 8 + wave, NGW = gridDim.x * 8;
    const float* g = p.in[18];
    const bf16_t* XB = (const bf16_t*)(p.ws + WS_XB); const float* ssq = (const float*)(p.ws + WS_SSQ);
    f32x4 gg[2][2];
#pragma unroll
    for (int j = 0; j < 2; ++j) { gg[j][0] = *(const f32x4*)(g + 512 * j + 8 * lane); gg[j][1] = *(const f32x4*)(g + 512 * j + 8 * lane + 4); }
    for (int rb = gw; rb < R; rb += 4 * NGW) {
        u32x4 xv[4][2]; f32x4 sq[4][4];
#pragma unroll
        for (int i = 0; i < 4; ++i) { const int r = rb + i * NGW; if (r < R) {
#pragma unroll
            for (int k = 0; k < 4; ++k) sq[i][k] = *(const f32x4*)(ssq + (size_t)r * 16 + 4 * k);
#pragma unroll
            for (int j = 0; j < 2; ++j) xv[i][j] = *(const u32x4*)(XB + (size_t)r * D + 512 * j + 8 * lane); } }
#pragma unroll
        for (int i = 0; i < 4; ++i) { const int r = rb + i * NGW; if (r < R) {
            const f32x4 a = sq[i][0], b4 = sq[i][1], c = sq[i][2], d = sq[i][3];
            const float s = ((a.x + a.y) + (a.z + a.w)) + ((b4.x + b4.y) + (b4.z + b4.w)) + ((c.x + c.y) + (c.z + c.w)) + ((d.x + d.y) + (d.z + d.w));
            const float rs = rsqrtf(s * (1.0f / D) + EPS);
            float* yr = p.out + (size_t)r * D;
#pragma unroll
            for (int j = 0; j < 2; ++j) { const u32x4 v = xv[i][j];
                *(f32x4*)(yr + 512 * j + 8 * lane) = (f32x4){bf_lo(v.x), bf_hi(v.x), bf_lo(v.y), bf_hi(v.y)} * rs * gg[j][0];
                *(f32x4*)(yr + 512 * j + 8 * lane + 4) = (f32x4){bf_lo(v.z), bf_hi(v.z), bf_lo(v.w), bf_hi(v.w)} * rs * gg[j][1]; } } }
    }
}

#define XB_TMO      128
#define XB_XCNT(j)  (256  + 64 * (j))
#define XB_XSUB(j)  (1280 + 64 * (j))
#define XB_XGEN(j)  (2304 + 64 * (j))
#define XB_TOP      3328
#define XB_TOPGEN   3392
#define XCD_BAR_WORDS 3456
#define XB_SPIN_CAP (1u << 22)
__device__ __forceinline__ unsigned xb_ld(unsigned* p)              { return __hip_atomic_load(p, __ATOMIC_RELAXED, __HIP_MEMORY_SCOPE_AGENT); }
__device__ __forceinline__ unsigned xb_add(unsigned* p, unsigned v) { return __hip_atomic_fetch_add(p, v, __ATOMIC_RELAXED, __HIP_MEMORY_SCOPE_AGENT); }
__device__ __forceinline__ unsigned xb_xcc_id() { return (unsigned)__builtin_amdgcn_s_getreg((3 << 11) | 20) & 0xFu; }
#define XB_SPIN(cond, bar) do { unsigned _sp = 0; while (cond) { __builtin_amdgcn_s_sleep(1); \
    if ((++_sp & 255u) == 0u) { if (xb_ld(&(bar)[XB_TMO])) break; if (_sp > XB_SPIN_CAP) { atomicAdd(&(bar)[XB_TMO], 1u); break; } } } } while (0)
struct XcdBarrier { unsigned* bar; unsigned x; volatile LAS unsigned* st; };
__device__ __forceinline__ XcdBarrier xcd_barrier_post(unsigned* bar, volatile LAS unsigned* st) {
    XcdBarrier b; b.bar = bar; b.x = xb_xcc_id(); b.st = st;
    if (threadIdx.x == 0) (void)xb_add(&bar[XB_XCNT(b.x)], 1u);
    return b;
}
__device__ __forceinline__ void xcd_barrier_complete(unsigned* bar, unsigned x, unsigned& nloc, unsigned& nx) {
    const unsigned G = gridDim.x * gridDim.y * gridDim.z;
    unsigned sum, cnt, mine, sp = 0u;
    for (;;) {
        sum = 0u; cnt = 0u; mine = 0u;
#pragma unroll
        for (unsigned j = 0; j < 16; ++j) { const unsigned c = xb_ld(&bar[XB_XCNT(j)]); sum += c; cnt += (c > 0u) ? 1u : 0u; mine = (j == x) ? c : mine; }
        if (sum == G) break;
        __builtin_amdgcn_s_sleep(1);
        if ((++sp & 255u) == 0u) { if (xb_ld(&bar[XB_TMO])) break; if (sp > XB_SPIN_CAP) { atomicAdd(&bar[XB_TMO], 1u); break; } }
    }
    nloc = mine > 0u ? mine : 1u; nx = cnt > 0u ? cnt : 1u;
}
__device__ __forceinline__ void xcd_barrier(const XcdBarrier& b) {
    asm volatile("s_waitcnt vmcnt(0)" ::: "memory");
    __syncthreads();
    if (threadIdx.x == 0) {
        unsigned* bar = b.bar;
        __builtin_amdgcn_s_waitcnt(0);
        unsigned nloc = b.st[0], nx = b.st[1];
        if (nloc == 0u) { xcd_barrier_complete(bar, b.x, nloc, nx); b.st[0] = nloc; b.st[1] = nx; }
        const unsigned old = xb_add(&bar[XB_XSUB(b.x)], 1u);
        const unsigned gen = old / nloc;
        if (old + 1u == (gen + 1u) * nloc) {
            __builtin_amdgcn_fence(__ATOMIC_RELEASE, "agent");
            asm volatile("s_waitcnt vmcnt(0)" ::: "memory");
            const unsigned og = xb_add(&bar[XB_TOP], 1u);
            const unsigned tg = og / nx;
            if (og + 1u == (tg + 1u) * nx) xb_add(&bar[XB_TOPGEN], 1u);
            else XB_SPIN(xb_ld(&bar[XB_TOPGEN]) == tg, bar);
            __builtin_amdgcn_fence(__ATOMIC_ACQUIRE, "agent");
            xb_add(&bar[XB_XGEN(b.x)], 1u);
            asm volatile("s_waitcnt vmcnt(0)" ::: "memory");
        } else {
            XB_SPIN(xb_ld(&bar[XB_XGEN(b.x)]) == gen, bar);
            __builtin_amdgcn_fence(__ATOMIC_ACQUIRE, "agent");
            asm volatile("s_waitcnt vmcnt(0)" ::: "memory");
        }
    }
    __syncthreads();
}

__global__ void __launch_bounds__(512, 2) fwd_megakernel(Params p_unused) {
    extern __shared__ __attribute__((aligned(16))) unsigned char lds_raw[];
    LAS unsigned char* lds = (LAS unsigned char*)lds_raw;
    cg::grid_group grid = cg::this_grid();
    volatile LAS unsigned* bst = (volatile LAS unsigned*)(lds + LDS_BYTES - 16);
    if (threadIdx.x == 0) { bst[0] = 0u; bst[1] = 0u; }
    __syncthreads();
    const XcdBarrier xbar = xcd_barrier_post((unsigned*)(kparams()->ws + WS_BAR), bst);

#ifndef NO_PRO
    prologue(lds, kparams());
#endif
    if (kparams()->ws == nullptr) grid.sync();
    { XcdBarrier xb_; xb_.bar = (unsigned*)(kparams()->ws + WS_BAR); xb_.x = xb_xcc_id(); xb_.st = (volatile LAS unsigned*)(lds + LDS_BYTES - 16); xcd_barrier(xb_); }
#pragma unroll 1
    for (int l = 0; l < NLAYER; ++l) {
        {
            KP q = kparams(); unsigned char* ws = q->ws; const int G = gridDim.x, c = blockIdx.x;
            bf16_t* XB = (bf16_t*)(ws + WS_XB); float* ssq = (float*)(ws + WS_SSQ); bf16_t* Z = (bf16_t*)(ws + WS_Z);
            pg8::Gemm g{XB, (const bf16_t*)(ws + WS_WIN) + (size_t)l * DIN * D, D}; pg8::Order S; S.init(DIN, G, c);
            pg8::EpiZ E{Z, ssq, (LAS float*)(lds + pg8::STAGE_BYTES), -1};
#ifndef NO_THIN
            thin_z(lds, XB, g.Bt, ssq, Z);
#endif
#ifndef NO_G1
            pg8::gemm_phase<pg8::EpiZ, pg8::Order, true, true>(lds, g, S, E);
#endif
        }
        xcd_barrier(xbar);
#ifndef NO_MIX
        mixer_phase(lds, kparams(), l);
#endif
        xcd_barrier(xbar);
        {
            KP q = kparams(); unsigned char* ws = q->ws; const int G = gridDim.x, c = blockIdx.x;
            bf16_t* XB = (bf16_t*)(ws + WS_XB); float* ssq = (float*)(ws + WS_SSQ); bf16_t* Y = (bf16_t*)(ws + WS_Y);
            pg8::Gemm g{Y, (const bf16_t*)(ws + WS_WOUT) + (size_t)l * D * D, D}; pg8::Order S; S.init(D, G, c);
            pg8::EpiRes E{XB, ssq, nullptr};
#ifndef NO_THIN
            thin_res(lds, Y, g.Bt, D, XB, ssq, nullptr);
#endif
#ifndef NO_G24
            pg8::gemm_phase<pg8::EpiRes, pg8::Order, true, true>(lds, g, S, E);
#endif
        }
        xcd_barrier(xbar);
        {
            KP q = kparams(); unsigned char* ws = q->ws; const int G = gridDim.x, c = blockIdx.x;
            bf16_t* XB = (bf16_t*)(ws + WS_XB); float* ssq = (float*)(ws + WS_SSQ); bf16_t* ACT = (bf16_t*)(ws + WS_ACT);
            pg8::Gemm g{XB, (const bf16_t*)(ws + WS_WUP) + (size_t)l * DUP * D, D}; pg8::Order S; S.init(DUP, G, c);
            pg8::EpiAct E{ACT, ssq, (float*)(ws + WS_HALO), q->in[15] + (size_t)l * 3 * DUP, q->in[16] + (size_t)l * DUP, (LAS float*)(lds + pg8::STAGE_BYTES), -1};
#ifndef NO_THINA
            thin_act(XB, g.Bt, ssq, ACT, E.wf, E.bfc, q->in[4] + (size_t)l * NBS * 2 * DUP, q->out + O_FFNS + (size_t)l * NBS * 2 * DUP);
#endif
#ifndef NO_G3
            pg8::gemm_phase<pg8::EpiAct, pg8::Order, true, true>(lds, g, S, E);
#endif
        }
        xcd_barrier(xbar);
#ifndef NO_FIX
        fixup_phase(kparams(), l);
#endif
        xcd_barrier(xbar);
        {
            KP q = kparams(); unsigned char* ws = q->ws; const int G = gridDim.x, c = blockIdx.x;
            bf16_t* XB = (bf16_t*)(ws + WS_XB); float* ssq = (float*)(ws + WS_SSQ); bf16_t* ACT = (bf16_t*)(ws + WS_ACT);
            pg8::Gemm g{ACT, (const bf16_t*)(ws + WS_WDN) + (size_t)l * D * DFF, DFF}; pg8::Order S; S.init(D, G, c);
            pg8::EpiRes E{XB, ssq, nullptr};
#ifndef NO_THIN
            thin_res(lds, ACT, g.Bt, DFF, XB, ssq, E.xout);
#endif
#ifndef NO_G24
            pg8::gemm_phase<pg8::EpiRes, pg8::Order, true, true>(lds, g, S, E);
#endif
        }
        xcd_barrier(xbar);
    }
    final_phase(kparams());
}

extern "C" void kernel_launch(void* const* d_in, const int* in_sizes, int n_in, void* d_out, int out_size, void* d_ws, size_t ws_size, hipStream_t stream) {
    static int grid = 0;
    if (grid == 0) {
        int dev = 0, cus = 0, per_cu = 0;
        (void)hipGetDevice(&dev);
        (void)hipDeviceGetAttribute(&cus, hipDeviceAttributeMultiprocessorCount, dev);
        (void)hipFuncSetAttribute((const void*)fwd_megakernel, hipFuncAttributeMaxDynamicSharedMemorySize, LDS_BYTES);
        (void)hipOccupancyMaxActiveBlocksPerMultiprocessor(&per_cu, (const void*)fwd_megakernel, 512, LDS_BYTES);
        if (n_in != 19 || (size_t)out_size != O_END || ws_size < WS_END) { fprintf(stderr, "kernel_launch: unexpected shapes: n_in %d out_size %d ws_size %zu (need %zu)\n", n_in, out_size, ws_size, (size_t)WS_END); }
        if (per_cu < 1) { fprintf(stderr, "kernel_launch: occupancy query says %d blocks per CU\n", per_cu); per_cu = 1; }
        grid = cus > 0 ? cus : 256;
    }
    Params p{};
    for (int i = 0; i < 19; ++i) p.in[i] = (const float*)d_in[i];
    p.out = (float*)d_out; p.ws = (unsigned char*)d_ws;
    (void)hipMemsetAsync((unsigned char*)d_ws + WS_BAR, 0, 16384, stream);
    void* args[] = {&p};
    hipError_t e = hipLaunchCooperativeKernel((const void*)fwd_megakernel, dim3(grid), dim3(512), args, LDS_BYTES, stream);
    if (e != hipSuccess) fprintf(stderr, "cooperative launch failed: %s (grid %d)\n", hipGetErrorString(e), grid);
}
```

```cpp
#include <hip/hip_runtime.h>
#include <hip/hip_cooperative_groups.h>
#include <cstdio>
#include <cstdint>
namespace cg = cooperative_groups;

#define LAS __attribute__((address_space(3)))
typedef unsigned short bf16_t;
typedef short bf16x8 __attribute__((ext_vector_type(8)));
typedef float f32x4 __attribute__((ext_vector_type(4)));
typedef float f32x2 __attribute__((ext_vector_type(2)));
typedef unsigned u32x4 __attribute__((ext_vector_type(4)));
typedef unsigned u32x2 __attribute__((ext_vector_type(2)));

constexpr int D = 1024, DIN = 2048, DFF = 2816, DUP = 5632, NLAYER = 4;
constexpr int RP = 32768, RS = 256, R = RP + RS, SEQ = 16384, DSEQ = 32, NBP = 2, NBS = 8;
constexpr float EPS = 1e-6f;
constexpr int NSEG = R / 64;
constexpr size_t WS_WIN = 0;
constexpr size_t WS_WOUT = WS_WIN + (size_t)NLAYER * DIN * D * 2;
constexpr size_t WS_WUP = WS_WOUT + (size_t)NLAYER * D * D * 2;
constexpr size_t WS_WDN = WS_WUP + (size_t)NLAYER * DUP * D * 2;
constexpr size_t WS_WPT = WS_WDN + (size_t)NLAYER * D * DFF * 2;
constexpr size_t WS_WSB = WS_WPT + (size_t)NLAYER * 4 * 64 * 64 * 2;
constexpr size_t WS_SSQ = WS_WSB + (size_t)NLAYER * 4 * 128 * 128 * 2;
constexpr size_t WS_XB = WS_SSQ + (size_t)R * 16 * 4;
constexpr size_t WS_HALO = WS_XB + (size_t)R * D * 2;
constexpr size_t WS_HALOS = WS_HALO + (size_t)NSEG * 4 * DUP * 4;
constexpr size_t WS_BIG = WS_HALOS + (size_t)4 * 4 * DUP * 4;
constexpr size_t WS_Z = WS_BIG;
constexpr size_t WS_Y = WS_Z + (size_t)R * DIN * 2;
constexpr size_t WS_ACT = WS_BIG;
constexpr size_t WS_BAR = WS_Y + (size_t)R * D * 2;
constexpr size_t WS_END = WS_BAR + 16384;
static_assert((size_t)R * DFF * 2 <= WS_BAR - WS_BIG, "ACT overlay");
constexpr size_t O_Y = 0;
constexpr size_t O_POOLP = (size_t)R * D;
constexpr size_t O_CONVP = O_POOLP + (size_t)NLAYER * NBP * 15 * 256;
constexpr size_t O_FFNP = O_CONVP + (size_t)NLAYER * NBP * 2 * 256;
constexpr size_t O_POOLS = O_FFNP + (size_t)NLAYER * NBP * 2 * DUP;
constexpr size_t O_CONVS = O_POOLS + (size_t)NLAYER * NBS * 15 * 256;
constexpr size_t O_FFNS = O_CONVS + (size_t)NLAYER * NBS * 2 * 256;
constexpr size_t O_VS = O_FFNS + (size_t)NLAYER * NBS * 2 * DUP;
constexpr size_t O_END = O_VS + (size_t)NLAYER * NBS * DSEQ * 512;

constexpr int LDS_BYTES = 144 * 1024;

__device__ __forceinline__ unsigned cvt_pk_bf16(float lo, float hi) { unsigned r; asm volatile("v_cvt_pk_bf16_f32 %0, %1, %2" : "=v"(r) : "v"(lo), "v"(hi)); return r; }
__device__ __forceinline__ float bf_lo(unsigned w) { return __uint_as_float(w << 16); }
__device__ __forceinline__ float bf_hi(unsigned w) { return __uint_as_float(w & 0xffff0000u); }
__device__ __forceinline__ float dpp_ror1(float v) { return __int_as_float(__builtin_amdgcn_update_dpp(0, __float_as_int(v), 0x121, 0xf, 0xf, false)); }
__device__ __forceinline__ float dpp_ror2(float v) { return __int_as_float(__builtin_amdgcn_update_dpp(0, __float_as_int(v), 0x122, 0xf, 0xf, false)); }
__device__ __forceinline__ float wave_sum(float v) {
#pragma unroll
    for (int o = 1; o < 64; o <<= 1) v += __shfl_xor(v, o);
    return v;
}
__device__ __forceinline__ float rstd_of(const float* ssq_row) {
    const f32x4 a = *(const f32x4*)(ssq_row), b = *(const f32x4*)(ssq_row + 4), c = *(const f32x4*)(ssq_row + 8), d = *(const f32x4*)(ssq_row + 12);
    const float s = ((a.x + a.y) + (a.z + a.w)) + ((b.x + b.y) + (b.z + b.w)) + ((c.x + c.y) + (c.z + c.w)) + ((d.x + d.y) + (d.z + d.w));
    return rsqrtf(s * (1.0f / D) + EPS);
}

__device__ __forceinline__ void row_rstd_to_lds(const float* ssq, int pm, LAS float* rl) {
    int tid = threadIdx.x; asm volatile("" : "+v"(tid)); const int row = tid >> 1;
    const float* sp = ssq + ((size_t)pm * 256 + row) * 16 + (tid & 1) * 8;
    const f32x4 a = *(const f32x4*)sp, b = *(const f32x4*)(sp + 4);
    float s = ((a.x + a.y) + (a.z + a.w)) + ((b.x + b.y) + (b.z + b.w));
    s += __shfl_xor(s, 1);
    if ((tid & 1) == 0) rl[row] = rsqrtf(s * (1.0f / D) + EPS);
    asm volatile("s_waitcnt lgkmcnt(0)" ::: "memory"); __builtin_amdgcn_s_barrier(); asm volatile("" ::: "memory");
}

namespace pg8 {
constexpr int BM = 256, BK = 64, HALF = 128, HTB = HALF * BK * 2, STAGE_BYTES = 8 * HTB;
__host__ __device__ __forceinline__ int lds_byte(int r, int c) { const int st = (r >> 4) * 2 + (c >> 5), rr = r & 15, cc = c & 31, ob = rr * 64 + cc * 2; return st * 1024 + (ob ^ (((ob >> 9) & 1) << 5)); }
__host__ __device__ __forceinline__ void stage_rc(int b, int& R_, int& C) { const int st = b / 1024, sb = b % 1024, swz = sb ^ (((sb >> 9) & 1) << 5); R_ = (st >> 1) * 16 + swz / 64; C = (st & 1) * 32 + (swz % 64) / 2; }
__host__ __device__ __forceinline__ int perm32(int rho) { const int n = rho >> 4, i = rho & 15; return 8 * (i >> 2) + 4 * n + (i & 3); }

struct Unit { int pm, pn; };
struct Gemm { const bf16_t* A; const bf16_t* Bt; int K; };

struct Order {
    int nN, nwgP, nwg, G, c;
    __device__ __forceinline__ void init(int N, int G_, int c_) { nN = N / BM; nwgP = 128 * nN; nwg = nwgP; G = G_; c = c_; }
    __device__ __forceinline__ bool next(int i, Unit& u) const {
        const int L = i * G + c; if (L >= nwg) return false;
        if (L >= nwgP) { u.pm = 128; u.pn = L - nwgP; return true; }
        const int q = nwgP / 8; const int wgid = (L % 8) * q + L / 8;
        const int nig = 8 * nN, gid = wgid / nig, w = wgid % nig;
        u.pm = gid * 8 + (w % 8); u.pn = w / 8; return true;
    }
    __device__ __forceinline__ void a_ready(const Unit&) const {}
    __device__ __forceinline__ void done(const Unit&) const {}
};

template <class Epi, class Sched, bool ALIGN_EPI = false, bool SP2 = false>
__device__ __forceinline__ void gemm_phase(LAS unsigned char* lds, const Gemm g, const Sched& S, const Epi& E) {
    int tid = threadIdx.x; asm volatile("" : "+v"(tid));
    const int wid = __builtin_amdgcn_readfirstlane(tid >> 6), lane = tid & 63, wr = wid >> 2, wc = wid & 3, fr = lane & 15, fq = lane >> 4;
    const int K = g.K, nt = K / BK;
    unsigned voffA[2], voffB[2];
#pragma unroll
    for (int i = 0; i < 2; ++i) { int R_, C; stage_rc(tid * 16 + i * 8192, R_, C); const int Rb = Epi::PERM ? ((R_ & ~31) + perm32(R_ & 31)) : R_;
        const int Ra = Epi::PERMA ? ((R_ & ~63) + 4 * (R_ & 15) + ((R_ >> 4) & 3)) : R_;
        voffA[i] = (unsigned)(Ra * K + C) * 2u; voffB[i] = (unsigned)(Rb * K + C) * 2u; }
    const size_t kstep = (size_t)(BK * 2);
    const size_t hstep = (size_t)HALF * K * 2;
    const size_t tstep = 2 * hstep;
    const unsigned ldsw = (unsigned)wid * 1024u;
    const int aoff = lds_byte(wr * 64 + fr, fq * 8), boff = lds_byte(wc * 32 + fr, fq * 8);
#define PG8_SA(b, h) (((b) * 2 + (h)) * HTB)
#define PG8_SB(b, h) ((4 + (b) * 2 + (h)) * HTB)
#define PG8_STAGE(bufoff, gbase, voff) do { _Pragma("unroll") for (int _i = 0; _i < 2; ++_i) \
        __builtin_amdgcn_global_load_lds((const unsigned*)((const char*)(gbase) + (voff)[_i]), (LAS unsigned*)(lds + (bufoff) + ldsw + _i * 8192), 16, 0, 0); } while (0)
#define PG8_LDA(dst, b, h) do { _Pragma("unroll") for (int m = 0; m < 4; ++m) _Pragma("unroll") for (int k = 0; k < 2; ++k) dst[m][k] = *(const LAS bf16x8*)(lds + PG8_SA(b, h) + aoff + m * 2048 + k * 1024); } while (0)
#define PG8_LDB(dst, b, h) do { _Pragma("unroll") for (int n = 0; n < 2; ++n) _Pragma("unroll") for (int k = 0; k < 2; ++k) dst[n][k] = *(const LAS bf16x8*)(lds + PG8_SB(b, h) + boff + n * 2048 + k * 1024); } while (0)
#define PG8_MMA(ai, bj, At, Bt) do { __builtin_amdgcn_s_setprio(1); _Pragma("unroll") for (int m = 0; m < 4; ++m) _Pragma("unroll") for (int n = 0; n < 2; ++n) _Pragma("unroll") for (int k = 0; k < 2; ++k) \
        acc[ai][bj][m][n] = __builtin_amdgcn_mfma_f32_16x16x32_bf16(Bt[n][k], At[m][k], acc[ai][bj][m][n], 0, 0, 0); __builtin_amdgcn_s_setprio(0); } while (0)
#define PG8_WAIT_V(n) asm volatile("s_waitcnt vmcnt(" #n ")" ::: "memory")
#define PG8_WAIT_L(n) asm volatile("s_waitcnt lgkmcnt(" #n ")" ::: "memory")
#define PG8_WAIT_VR(rel) do { if constexpr (Epi::EPI_VM == 16) asm volatile("s_waitcnt vmcnt(24)\n\ts_cmp_lg_u32 %0, 0\n\ts_cbranch_scc1 1\n\ts_waitcnt vmcnt(8)" :: "s"(rel) : "scc", "memory"); \
        else if constexpr (Epi::EPI_VM == 32) asm volatile("s_waitcnt vmcnt(40)\n\ts_cmp_lg_u32 %0, 0\n\ts_cbranch_scc1 1\n\ts_waitcnt vmcnt(8)" :: "s"(rel) : "scc", "memory"); \
        else asm volatile("s_waitcnt vmcnt(8)" ::: "memory"); } while (0)
#define PG8_BAR __builtin_amdgcn_s_barrier()
#define PG8_SCHED __builtin_amdgcn_sched_barrier(0)
    Unit cur, nxt; int ui = 0;
    if (!S.next(0, cur)) return;
    f32x4 acc[2][2][4][2];
#pragma unroll
    for (int a = 0; a < 2; ++a)
#pragma unroll
        for (int b = 0; b < 2; ++b)
#pragma unroll
            for (int m = 0; m < 4; ++m)
#pragma unroll
                for (int n = 0; n < 2; ++n) acc[a][b][m][n] = (f32x4){0.f, 0.f, 0.f, 0.f};
    bf16x8 At[4][2], B0[2][2], B1[2][2];
    const char* cA = (const char*)g.A + (size_t)cur.pm * tstep; const char* cB = (const char*)g.Bt + (size_t)cur.pn * tstep;
    S.a_ready(cur);
    if constexpr (SP2) {
        PG8_STAGE(PG8_SB(0, 0), cB, voffB); PG8_STAGE(PG8_SB(0, 1), cB + hstep, voffB); PG8_STAGE(PG8_SA(0, 0), cA, voffA); PG8_STAGE(PG8_SA(0, 1), cA + hstep, voffA);
        if (wr == 1) PG8_BAR;
        PG8_WAIT_V(2); PG8_BAR;
        PG8_STAGE(PG8_SB(1, 0), cB + kstep, voffB); PG8_STAGE(PG8_SA(1, 0), cA + kstep, voffA); PG8_STAGE(PG8_SB(1, 1), cB + hstep + kstep, voffB);
        PG8_WAIT_V(6); PG8_BAR;
    } else {
        PG8_STAGE(PG8_SB(0, 0), cB, voffB); PG8_STAGE(PG8_SA(0, 0), cA, voffA); PG8_STAGE(PG8_SB(0, 1), cB + hstep, voffB); PG8_STAGE(PG8_SA(0, 1), cA + hstep, voffA);
        if (wr == 1) PG8_BAR;
        PG8_WAIT_V(4); PG8_BAR;
        PG8_STAGE(PG8_SB(1, 0), cB + kstep, voffB); PG8_STAGE(PG8_SA(1, 0), cA + kstep, voffA); PG8_STAGE(PG8_SB(1, 1), cB + hstep + kstep, voffB);
        PG8_WAIT_V(6); PG8_BAR;
    }
    for (;;) {
        const bool has_next = S.next(ui + 1, nxt);
        const char* nA = has_next ? (const char*)g.A + (size_t)nxt.pm * tstep : cA; const char* nB = has_next ? (const char*)g.Bt + (size_t)nxt.pn * tstep : cB;
        for (int t = 0; t < nt; t += 2) {
            const bool last = (t == nt - 2);
            const char* a1 = cA + (size_t)(t + 1) * kstep;
            const char* a2 = last ? nA : cA + (size_t)(t + 2) * kstep; const char* b2 = last ? nB : cB + (size_t)(t + 2) * kstep;
            const char* a3 = a2 + kstep; const char* b3 = b2 + kstep;
            if (last && has_next) S.a_ready(nxt);
            if constexpr (SP2) {
            const int relaxed = __builtin_amdgcn_readfirstlane((t == 0 && ui > 0) ? 1 : 0);
            PG8_LDB(B0, 0, 0); PG8_LDB(B1, 0, 1); PG8_SCHED; PG8_LDA(At, 0, 0); PG8_STAGE(PG8_SA(1, 1), a1 + hstep, voffA);
            PG8_WAIT_VR(relaxed); PG8_WAIT_L(0); PG8_BAR; PG8_MMA(0, 0, At, B0); PG8_MMA(0, 1, At, B1); PG8_BAR; PG8_SCHED;
            PG8_LDA(At, 0, 1); PG8_STAGE(PG8_SB(0, 0), b2, voffB); PG8_STAGE(PG8_SB(0, 1), b2 + hstep, voffB); PG8_STAGE(PG8_SA(0, 0), a2, voffA);
            PG8_WAIT_VR(relaxed); PG8_WAIT_L(0); PG8_BAR; PG8_MMA(1, 0, At, B0); PG8_MMA(1, 1, At, B1); PG8_BAR; PG8_SCHED;
            PG8_LDB(B0, 1, 0); PG8_LDB(B1, 1, 1); PG8_SCHED; PG8_LDA(At, 1, 0); PG8_STAGE(PG8_SA(0, 1), a2 + hstep, voffA);
            PG8_WAIT_V(8); PG8_WAIT_L(0); PG8_BAR; PG8_MMA(0, 0, At, B0); PG8_MMA(0, 1, At, B1); PG8_BAR; PG8_SCHED;
            PG8_LDA(At, 1, 1); PG8_STAGE(PG8_SB(1, 0), b3, voffB); PG8_STAGE(PG8_SB(1, 1), b3 + hstep, voffB); PG8_STAGE(PG8_SA(1, 0), a3, voffA);
            PG8_WAIT_V(8); PG8_WAIT_L(0); PG8_BAR; PG8_MMA(1, 0, At, B0); PG8_MMA(1, 1, At, B1); PG8_BAR; PG8_SCHED;
            } else {
            PG8_LDB(B0, 0, 0); PG8_SCHED; PG8_LDA(At, 0, 0); PG8_STAGE(PG8_SA(1, 1), a1 + hstep, voffA);
            PG8_WAIT_L(8); PG8_BAR; PG8_WAIT_L(0); PG8_MMA(0, 0, At, B0); PG8_BAR; PG8_SCHED;
            PG8_LDB(B1, 0, 1); PG8_STAGE(PG8_SB(0, 0), b2, voffB);
            PG8_BAR; PG8_WAIT_L(0); PG8_MMA(0, 1, At, B1); PG8_BAR;
            PG8_LDA(At, 0, 1); PG8_STAGE(PG8_SA(0, 0), a2, voffA);
            PG8_BAR; PG8_WAIT_L(0); PG8_MMA(1, 0, At, B0); PG8_BAR; PG8_SCHED;
            PG8_STAGE(PG8_SB(0, 1), b2 + hstep, voffB);
            PG8_WAIT_V(6); PG8_BAR; PG8_MMA(1, 1, At, B1); PG8_BAR;
            PG8_LDB(B0, 1, 0); PG8_SCHED; PG8_LDA(At, 1, 0); PG8_STAGE(PG8_SA(0, 1), a2 + hstep, voffA);
            PG8_WAIT_L(8); PG8_BAR; PG8_WAIT_L(0); PG8_MMA(0, 0, At, B0); PG8_BAR; PG8_SCHED;
            PG8_LDB(B1, 1, 1); PG8_STAGE(PG8_SB(1, 0), b3, voffB);
            PG8_BAR; PG8_WAIT_L(0); PG8_MMA(0, 1, At, B1); PG8_BAR;
            PG8_LDA(At, 1, 1); PG8_STAGE(PG8_SA(1, 0), a3, voffA);
            PG8_BAR; PG8_WAIT_L(0); PG8_MMA(1, 0, At, B0); PG8_BAR; PG8_SCHED;
            PG8_STAGE(PG8_SB(1, 1), b3 + hstep, voffB);
            PG8_WAIT_V(6); PG8_BAR; PG8_MMA(1, 1, At, B1); PG8_BAR;
            }
        }
        if constexpr (ALIGN_EPI) { if (wr == 0) PG8_BAR; }
        E(acc, cur, wr, wc, fr, fq); S.done(cur);
        if (!has_next) break;
#pragma unroll
        for (int a = 0; a < 2; ++a)
#pragma unroll
            for (int b = 0; b < 2; ++b)
#pragma unroll
                for (int m = 0; m < 4; ++m)
#pragma unroll
                    for (int n = 0; n < 2; ++n) acc[a][b][m][n] = (f32x4){0.f, 0.f, 0.f, 0.f};
        cur = nxt; cA = nA; cB = nB; ++ui;
        if constexpr (ALIGN_EPI) { if (wr == 1) PG8_BAR; }
    }
    PG8_WAIT_V(0);
    if constexpr (!ALIGN_EPI) { if (wr == 0) PG8_BAR; }
    PG8_BAR;
#undef PG8_SA
#undef PG8_SB
#undef PG8_STAGE
#undef PG8_LDA
#undef PG8_LDB
#undef PG8_MMA
#undef PG8_WAIT_V
#undef PG8_WAIT_VR
#undef PG8_WAIT_L
#undef PG8_BAR
#undef PG8_SCHED
}


struct EpiZ {
    static constexpr bool PERM = true, AFTER_DRAIN = false, PERMA = false; static constexpr int EPI_VM = 16;
    bf16_t* Z; const float* ssq; LAS float* rl; mutable int last_pm;
    __device__ __forceinline__ void operator()(const f32x4 (&acc)[2][2][4][2], const Unit& u, int wr, int wc, int fr, int fq) const {
        const int row0 = u.pm * BM + wr * 64 + fr, col0 = u.pn * BM + wc * 32 + 8 * fq;
        if (u.pm != last_pm) { row_rstd_to_lds(ssq, u.pm, rl); last_pm = u.pm; }
#pragma unroll
        for (int ai = 0; ai < 2; ++ai)
#pragma unroll
            for (int m = 0; m < 4; ++m) {
                const int r = row0 + ai * HALF + m * 16; const float rs = rl[ai * HALF + wr * 64 + m * 16 + fr];
                bf16_t* rowp = Z + (size_t)r * DIN + col0;
#pragma unroll
                for (int bj = 0; bj < 2; ++bj) { const f32x4 v0 = acc[ai][bj][m][0] * rs, v1 = acc[ai][bj][m][1] * rs;
                    u32x4 w; w.x = cvt_pk_bf16(v0[0], v0[1]); w.y = cvt_pk_bf16(v0[2], v0[3]); w.z = cvt_pk_bf16(v1[0], v1[1]); w.w = cvt_pk_bf16(v1[2], v1[3]);
                    *(u32x4*)(rowp + bj * HALF) = w; } }
    }
};

struct EpiRes {
    static constexpr bool PERM = true, AFTER_DRAIN = false, PERMA = false; static constexpr int EPI_VM = 32;
    bf16_t* XB; float* ssq; float* xout;
    __device__ __forceinline__ void operator()(const f32x4 (&acc)[2][2][4][2], const Unit& u, int wr, int wc, int fr, int fq) const {
        const int lrow0 = wr * 64 + fr, col0 = u.pn * BM + wc * 32 + 8 * fq;
        const size_t o0 = ((size_t)u.pm * BM + lrow0) * D + col0;
#pragma unroll
        for (int ai = 0; ai < 2; ++ai) {
        u32x4 xin[4][2];
#pragma unroll
        for (int m = 0; m < 4; ++m)
#pragma unroll
            for (int bj = 0; bj < 2; ++bj) xin[m][bj] = *(const u32x4*)(XB + o0 + (size_t)(ai * HALF + m * 16) * D + bj * HALF);
        asm volatile("" ::: "memory");
#pragma unroll
            for (int m = 0; m < 4; ++m) {
                const size_t ro = o0 + (size_t)(ai * HALF + m * 16) * D;
                float q = 0.f;
#pragma unroll
                for (int bj = 0; bj < 2; ++bj) {
                    const u32x4 xv = xin[m][bj];
                    const f32x4 x0 = (f32x4){bf_lo(xv.x), bf_hi(xv.x), bf_lo(xv.y), bf_hi(xv.y)} + acc[ai][bj][m][0];
                    const f32x4 x1 = (f32x4){bf_lo(xv.z), bf_hi(xv.z), bf_lo(xv.w), bf_hi(xv.w)} + acc[ai][bj][m][1];
                    q += ((x0[0] * x0[0] + x0[1] * x0[1]) + (x0[2] * x0[2] + x0[3] * x0[3])) + ((x1[0] * x1[0] + x1[1] * x1[1]) + (x1[2] * x1[2] + x1[3] * x1[3]));
                    if (xout) { *(f32x4*)(xout + ro + bj * HALF) = x0; *(f32x4*)(xout + ro + bj * HALF + 4) = x1; }
                    else { u32x4 w; w.x = cvt_pk_bf16(x0[0], x0[1]); w.y = cvt_pk_bf16(x0[2], x0[3]); w.z = cvt_pk_bf16(x1[0], x1[1]); w.w = cvt_pk_bf16(x1[2], x1[3]); *(u32x4*)(XB + ro + bj * HALF) = w; }
                }
                q += __shfl_xor(q, 16); q += __shfl_xor(q, 32);
                if (fq == 0) ssq[((size_t)u.pm * BM + lrow0 + ai * HALF + m * 16) * 16 + u.pn * 4 + wc] = q;
            }
        }
    }
};

struct EpiAct {
    static constexpr bool PERM = true, AFTER_DRAIN = false, PERMA = true; static constexpr int EPI_VM = 32;
    bf16_t* ACT; const float* ssq; float* halo; const float* wf; const float* bfc; LAS float* rl; mutable int last_pm;
    static __device__ __forceinline__ f32x4 shr1(const f32x4 v) { f32x4 r;
#pragma unroll
        for (int e = 0; e < 4; ++e) r[e] = __int_as_float(__builtin_amdgcn_update_dpp(0, __float_as_int(v[e]), 0x111, 0xf, 0xf, true));
        return r; }
    __device__ __forceinline__ void operator()(const f32x4 (&acc)[2][2][4][2], const Unit& u, int wr, int wc, int fr, int fq) const {
        const int cg0 = u.pn * 128 + wc * 32 + 8 * fq;
        if (u.pm != last_pm) { row_rstd_to_lds(ssq, u.pm, rl); last_pm = u.pm; }
        u32x2 keep[2][4];
#pragma unroll
        for (int n = 0; n < 2; ++n) {
            f32x4 w0[2], w1[2], w2[2], bb[2];
#pragma unroll
            for (int bj = 0; bj < 2; ++bj) { const int col = bj * DFF + cg0 + 4 * n;
                w0[bj] = *(const f32x4*)(wf + col); w1[bj] = *(const f32x4*)(wf + DUP + col); w2[bj] = *(const f32x4*)(wf + 2 * DUP + col); bb[bj] = *(const f32x4*)(bfc + col); }
#pragma unroll
            for (int ai = 0; ai < 2; ++ai) {
                const int lrow0 = ai * HALF + wr * 64 + 4 * fr; const int rseg = u.pm * BM + ai * HALF + wr * 64; const int seg = rseg >> 6;
                const f32x4 rs = *(const LAS f32x4*)(rl + lrow0);
                f32x4 og[4];
#pragma unroll
                for (int bj = 0; bj < 2; ++bj) {
                    f32x4 c[4];
#pragma unroll
                    for (int m = 0; m < 4; ++m) c[m] = acc[ai][bj][m][n] * rs[m];
                    if (fr == 0 || fr == 15) {
                        float* hp = halo + ((size_t)seg * 4 + (fr == 0 ? 0 : 2)) * DUP + bj * DFF + cg0 + 4 * n;
                        *(f32x4*)hp = (fr == 0) ? c[0] : c[2]; *(f32x4*)(hp + DUP) = (fr == 0) ? c[1] : c[3];
                    }
                    const f32x4 s2 = shr1(c[2]), s3 = shr1(c[3]);
                    const f32x4 o0 = bb[bj] + w0[bj] * s2 + w1[bj] * s3 + w2[bj] * c[0];
                    const f32x4 o1 = bb[bj] + w0[bj] * s3 + w1[bj] * c[0] + w2[bj] * c[1];
                    const f32x4 o2 = bb[bj] + w0[bj] * c[0] + w1[bj] * c[1] + w2[bj] * c[2];
                    const f32x4 o3 = bb[bj] + w0[bj] * c[1] + w1[bj] * c[2] + w2[bj] * c[3];
                    if (bj == 0) { og[0] = o0; og[1] = o1; og[2] = o2; og[3] = o3; }
                    else {
                        const f32x4 ov[4] = {o0, o1, o2, o3};
#pragma unroll
                        for (int m = 0; m < 4; ++m) {
                            f32x4 a0;
#pragma unroll
                            for (int e = 0; e < 4; ++e) { const float g0 = og[m][e]; a0[e] = g0 * ov[m][e] * __builtin_amdgcn_rcpf(1.0f + __builtin_amdgcn_exp2f(-1.4426950408889634f * g0)); }
                            u32x2 w; w.x = cvt_pk_bf16(a0[0], a0[1]); w.y = cvt_pk_bf16(a0[2], a0[3]);
                            if (n == 0) keep[ai][m] = w;
                            else if (!(fr == 0 && m < 2)) { u32x4 w4; w4.x = keep[ai][m].x; w4.y = keep[ai][m].y; w4.z = w.x; w4.w = w.y;
                                *(u32x4*)(ACT + (size_t)(rseg + 4 * fr + m) * DFF + cg0) = w4; }
                        }
                    }
                }
            }
        }
    }
};
}

struct Params { const float* in[19]; float* out; unsigned char* ws; };
typedef const Params __attribute__((address_space(4)))* KP;
__device__ __forceinline__ Params load_params(KP k) { Params p;
#pragma unroll
    for (int i = 0; i < 19; ++i) p.in[i] = k->in[i];
    p.out = k->out; p.ws = k->ws; return p; }
__device__ __forceinline__ KP kparams() { KP k = (KP)__builtin_amdgcn_kernarg_segment_ptr(); asm volatile("" : "+s"(k)); return k; }

__device__ __forceinline__ void transpose_item(const float* W, int K, int N, bf16_t* WT, int k0, int n0, int drow0, LAS float* scr, int lane, const float* gk) {
    float wv[32];
#pragma unroll
    for (int i = 0; i < 32; ++i) { const int kk = 2 * i + (lane >> 5); wv[i] = W[(size_t)(k0 + kk) * N + n0 + (lane & 31)]; }
#pragma unroll
    for (int i = 0; i < 32; ++i) { const int kk = 2 * i + (lane >> 5); const float gg = gk ? gk[k0 + kk] : 1.0f; scr[kk * 33 + (lane & 31)] = wv[i] * gg; }
    asm volatile("s_waitcnt lgkmcnt(0)" ::: "memory");
    const int c = lane & 7;
#pragma unroll
    for (int j = 0; j < 4; ++j) { const int n = (lane >> 3) + 8 * j; const LAS float* s = scr + (8 * c) * 33 + n;
        u32x4 o; o.x = cvt_pk_bf16(s[0 * 33], s[1 * 33]); o.y = cvt_pk_bf16(s[2 * 33], s[3 * 33]); o.z = cvt_pk_bf16(s[4 * 33], s[5 * 33]); o.w = cvt_pk_bf16(s[6 * 33], s[7 * 33]);
        *(u32x4*)(WT + (size_t)(drow0 + n) * K + k0 + 8 * c) = o; }
    asm volatile("s_waitcnt lgkmcnt(0)" ::: "memory");
}

__device__ __forceinline__ void prologue(LAS unsigned char* lds, KP pk) {
    const Params p = load_params(pk);
    const int tid = threadIdx.x, lane = tid & 63, wave = tid >> 6;
    const int gw = blockIdx.x * 8 + wave, NGW = gridDim.x * 8;
    LAS float* scr = (LAS float*)(lds + wave * 16384);
    unsigned char* ws = p.ws;
    constexpr int I_IN = (D / 64) * (DIN / 32), I_OUT = (D / 64) * (D / 32), I_UP = (D / 64) * (DUP / 32), I_DN = (DFF / 64) * (D / 32), I_L = I_IN + I_OUT + I_UP + I_DN;
    for (int it = gw; it < NLAYER * I_L; it += NGW) {
        const int l = it / I_L; int r = it % I_L;
        if (r < I_IN) { const int nblk = DIN / 32, kb = r / nblk, nb = r % nblk; transpose_item(p.in[6] + (size_t)l * D * DIN, D, DIN, (bf16_t*)(ws + WS_WIN) + (size_t)l * DIN * D, 64 * kb, 32 * nb, 32 * nb, scr, lane, p.in[5] + (size_t)l * D); continue; } r -= I_IN;
        if (r < I_OUT) { const int nblk = D / 32, kb = r / nblk, nb = r % nblk; transpose_item(p.in[12] + (size_t)l * D * D, D, D, (bf16_t*)(ws + WS_WOUT) + (size_t)l * D * D, 64 * kb, 32 * nb, 32 * nb, scr, lane, nullptr); continue; } r -= I_OUT;
        if (r < I_UP) { const int nblk = DUP / 32, kb = r / nblk, nb = r % nblk; const int n0 = 32 * nb;
            const int drow = (n0 < DFF) ? (n0 / 128) * 256 + (n0 % 128) : ((n0 - DFF) / 128) * 256 + 128 + ((n0 - DFF) % 128);
            transpose_item(p.in[14] + (size_t)l * D * DUP, D, DUP, (bf16_t*)(ws + WS_WUP) + (size_t)l * DUP * D, 64 * kb, n0, drow, scr, lane, p.in[13] + (size_t)l * D); continue; } r -= I_UP;
        { const int nblk = D / 32, kb = r / nblk, nb = r % nblk; transpose_item(p.in[17] + (size_t)l * DFF * D, DFF, D, (bf16_t*)(ws + WS_WDN) + (size_t)l * D * DFF, 64 * kb, 32 * nb, 32 * nb, scr, lane, nullptr); }
    }
    { bf16_t* wsb = (bf16_t*)(ws + WS_WSB); const float* wsrc = p.in[7];
      for (int i = (blockIdx.x * 512 + tid) * 2; i < NLAYER * 4 * 128 * 128; i += gridDim.x * 512 * 2) { const int k = i & 127, q = (i >> 7) & 127;
          const f32x2 v = *(const f32x2*)(wsrc + i); *(unsigned*)(wsb + i) = cvt_pk_bf16(k <= q ? v.x : 0.f, k + 1 <= q ? v.y : 0.f); } }
    { bf16_t* wpt = (bf16_t*)(ws + WS_WPT); const float* wp = p.in[9];
      for (int i = blockIdx.x * 512 + tid; i < NLAYER * 4 * 64 * 64; i += gridDim.x * 512) { const int c = i & 63, dd = (i >> 6) & 63, lg = i >> 12;
          wpt[i] = (bf16_t)(cvt_pk_bf16(wp[(size_t)lg * 4096 + c * 64 + dd], 0.f) & 0xffffu); } }
    { bf16_t* XB = (bf16_t*)(ws + WS_XB); float* ssq = (float*)(ws + WS_SSQ);
      for (int rb = gw; rb < R; rb += 4 * NGW) {
          f32x4 v[4][4];
#pragma unroll
          for (int i = 0; i < 4; ++i) { const int r = rb + i * NGW; if (r < R) { const float* xr = (r < RP) ? p.in[0] + (size_t)r * D : p.in[1] + (size_t)(r - RP) * D;
#pragma unroll
              for (int j = 0; j < 2; ++j) { v[i][2 * j] = *(const f32x4*)(xr + 512 * j + 8 * lane); v[i][2 * j + 1] = *(const f32x4*)(xr + 512 * j + 8 * lane + 4); } } }
#pragma unroll
          for (int i = 0; i < 4; ++i) { const int r = rb + i * NGW; if (r < R) { float s = 0.f;
#pragma unroll
              for (int j = 0; j < 2; ++j) { const f32x4 a = v[i][2 * j], c = v[i][2 * j + 1];
                  s += ((a.x * a.x + a.y * a.y) + (a.z * a.z + a.w * a.w)) + ((c.x * c.x + c.y * c.y) + (c.z * c.z + c.w * c.w));
                  u32x4 w; w.x = cvt_pk_bf16(a.x, a.y); w.y = cvt_pk_bf16(a.z, a.w); w.z = cvt_pk_bf16(c.x, c.y); w.w = cvt_pk_bf16(c.z, c.w); *(u32x4*)(XB + (size_t)r * D + 512 * j + 8 * lane) = w; }
              s = wave_sum(s);
              if (lane < 16) ssq[(size_t)r * 16 + lane] = (lane == 0) ? s : 0.f; } }
      } }
}

__device__ __forceinline__ void mixer_phase(LAS unsigned char* lds, KP pk, int l) {
    const Params p = load_params(pk);
    int tid = threadIdx.x; asm volatile("" : "+v"(tid));
    const int lane = tid & 63, w8 = __builtin_amdgcn_readfirstlane(tid >> 6), fr = lane & 15, fq = lane >> 4;
    unsigned char* ws = p.ws;
    const bf16_t* Z = (const bf16_t*)(ws + WS_Z); bf16_t* Y = (bf16_t*)(ws + WS_Y);
    const bf16_t* WPT = (const bf16_t*)(ws + WS_WPT) + (size_t)l * 4 * 64 * 64;
    const bf16_t* WSB = (const bf16_t*)(ws + WS_WSB) + (size_t)l * 4 * 128 * 128; const float* b_s = p.in[8] + (size_t)l * 4 * 128;
    const float* pscale = p.in[10] + (size_t)l * 256; const float* wcv = p.in[11] + (size_t)l * 3 * 256;
    float* out = p.out;
    LAS bf16_t* PB = (LAS bf16_t*)lds;
    LAS bf16_t* DM = (LAS bf16_t*)(lds + 143 * 512);
    LAS bf16_t* VT = (LAS bf16_t*)lds;
#pragma unroll 1
    for (int item = blockIdx.x; item < 256 + 40; item += gridDim.x) {
        const bool smp = item >= 256;
        const int L = smp ? 32 : 128;
        const int st = item - 256;
        const int b = smp ? (st < 32 ? st >> 2 : st - 32) : item >> 7;
        const int h0 = smp ? (st < 32 ? (st & 3) : 0) : 0, h1 = smp ? (st < 32 ? h0 + 1 : 0) : 4;
        const bool doBC = !smp || st >= 32;
        const int t0 = smp ? 0 : (item & 127) * 128;
        const int r0 = smp ? RP + 32 * b : item * 128;
        const bool fresh = smp || t0 == 0;
        const bool lastc = smp || (item & 127) == 127;
        const int pos0 = smp ? 4096 : t0;
        const float* st_pool = p.in[2] + ((size_t)l * NBS + b) * 15 * 256;
        const float* st_conv = p.in[3] + ((size_t)l * NBS + b) * 2 * 256;
        __syncthreads();
        if (doBC) {
        {
            const int npair = (L + 16) >> 1;
            for (int pi = (fresh ? 8 : 0) + w8; pi < npair; pi += 8) {
                const bf16_t* srcp = Z + (size_t)(r0 + 2 * pi - 15 + (lane >> 5)) * DIN + 1024 + (lane & 31) * 8;
                __builtin_amdgcn_global_load_lds((const unsigned*)srcp, (LAS unsigned*)(PB + pi * 512), 16, 0, 0);
            }
        }
#pragma unroll 1
        for (int half = 0; half < 2; ++half) {
            const int c8 = (tid & 31) * 8, RPB = L >> 5, ts = (tid >> 5) * 2 * RPB + half * RPB;
            u32x4 gcr[6], hcr[6], gbr[4];
            {
                const bf16_t* zb = Z + (size_t)(r0 + ts - 2) * DIN + c8;
#pragma unroll
                for (int i = 0; i < 6; ++i) if (i < RPB + 2 && (ts + i - 2 >= 0 || !fresh)) { gcr[i] = *(const u32x4*)(zb + (size_t)i * DIN + 1536); hcr[i] = *(const u32x4*)(zb + (size_t)i * DIN + 1792); }
#pragma unroll
                for (int i = 0; i < 4; ++i) if (i < RPB) gbr[i] = *(const u32x4*)(zb + (size_t)(i + 2) * DIN + 1280);
            }
            const f32x4 wa0 = *(const f32x4*)(wcv + c8), wb0 = *(const f32x4*)(wcv + c8 + 4), wa1 = *(const f32x4*)(wcv + 256 + c8), wb1 = *(const f32x4*)(wcv + 256 + c8 + 4), wa2 = *(const f32x4*)(wcv + 512 + c8), wb2 = *(const f32x4*)(wcv + 512 + c8 + 4);
            asm volatile("" ::: "memory");
            float q2[8], q1[8];
#pragma unroll
            for (int i = 0; i < 2; ++i) { const int tt = ts + i - 2; float qq[8];
                if (tt >= 0 || !fresh) {
#pragma unroll
                    for (int e = 0; e < 4; ++e) { qq[2 * e] = bf_lo(gcr[i][e]) * bf_lo(hcr[i][e]); qq[2 * e + 1] = bf_hi(gcr[i][e]) * bf_hi(hcr[i][e]); } }
                else if (smp) { const f32x4 a = *(const f32x4*)(st_conv + (2 + tt) * 256 + c8), bq = *(const f32x4*)(st_conv + (2 + tt) * 256 + c8 + 4);
#pragma unroll
                    for (int e = 0; e < 4; ++e) { qq[e] = a[e]; qq[4 + e] = bq[e]; } }
                else {
#pragma unroll
                    for (int e = 0; e < 8; ++e) qq[e] = 0.f; }
#pragma unroll
                for (int e = 0; e < 8; ++e) { if (i == 0) q2[e] = qq[e]; else q1[e] = qq[e]; } }
            bf16_t* yb = Y + (size_t)(r0 + ts) * D + 768 + c8;
#pragma unroll
            for (int i = 0; i < 4; ++i) if (i < RPB) {
                const int t = ts + i; const u32x4 gc = gcr[i + 2], hc = hcr[i + 2], gb = gbr[i];
                float q0[8], yv[8];
#pragma unroll
                for (int e = 0; e < 4; ++e) { q0[2 * e] = bf_lo(gc[e]) * bf_lo(hc[e]); q0[2 * e + 1] = bf_hi(gc[e]) * bf_hi(hc[e]); }
#pragma unroll
                for (int e = 0; e < 8; ++e) { const float w0 = (e < 4) ? wa0[e & 3] : wb0[e & 3], w1 = (e < 4) ? wa1[e & 3] : wb1[e & 3], w2 = (e < 4) ? wa2[e & 3] : wb2[e & 3];
                    const float cv = w0 * q2[e] + w1 * q1[e] + w2 * q0[e];
                    const float g = (e & 1) ? bf_hi(gb[e >> 1]) : bf_lo(gb[e >> 1]); yv[e] = g * cv; }
                u32x4 w; w.x = cvt_pk_bf16(yv[0], yv[1]); w.y = cvt_pk_bf16(yv[2], yv[3]); w.z = cvt_pk_bf16(yv[4], yv[5]); w.w = cvt_pk_bf16(yv[6], yv[7]);
                *(u32x4*)(yb + (size_t)i * D) = w;
                if (lastc && t >= L - 2) { float* o = out + (smp ? O_CONVS + ((size_t)l * NBS + b) * 512 : O_CONVP + ((size_t)l * NBP + b) * 512) + (t - (L - 2)) * 256 + c8;
                    *(f32x4*)o = (f32x4){q0[0], q0[1], q0[2], q0[3]}; *(f32x4*)(o + 4) = (f32x4){q0[4], q0[5], q0[6], q0[7]}; }
#pragma unroll
                for (int e = 0; e < 8; ++e) { q2[e] = q1[e]; q1[e] = q0[e]; }
            }
            asm volatile("" ::: "memory");
        }
        if (smp) for (int it = tid; it < 32 * 64; it += 512) { const int t = it >> 6, c8 = (it & 63) * 8; const u32x4 v = *(const u32x4*)(Z + (size_t)(r0 + t) * DIN + 512 + c8);
            float* o = out + O_VS + (((size_t)l * NBS + b) * 32 + t) * 512 + c8;
            *(f32x4*)o = (f32x4){bf_lo(v.x), bf_hi(v.x), bf_lo(v.y), bf_hi(v.y)}; *(f32x4*)(o + 4) = (f32x4){bf_lo(v.z), bf_hi(v.z), bf_lo(v.w), bf_hi(v.w)}; }
        if (fresh) { const int j = tid >> 5, c8 = (tid & 31) * 8; u32x4 v;
            if (j == 15) v = *(const u32x4*)(Z + (size_t)r0 * DIN + 1024 + c8);
            else if (smp) { const f32x4 a = *(const f32x4*)(st_pool + j * 256 + c8), bq = *(const f32x4*)(st_pool + j * 256 + c8 + 4);
                v.x = cvt_pk_bf16(a.x, a.y); v.y = cvt_pk_bf16(a.z, a.w); v.z = cvt_pk_bf16(bq.x, bq.y); v.w = cvt_pk_bf16(bq.z, bq.w); }
            else v = (u32x4){0u, 0u, 0u, 0u};
            *(LAS u32x4*)(PB + j * 256 + c8) = v; }
        asm volatile("s_waitcnt vmcnt(0)" ::: "memory");
        __syncthreads();
        if (lastc && tid < 15 * 32) {
            const int i15 = tid >> 5, c8 = (tid & 31) * 8; const u32x4 v = *(const LAS u32x4*)(PB + (L + i15) * 256 + c8);
            float* o = out + (smp ? O_POOLS + ((size_t)l * NBS + b) * 15 * 256 : O_POOLP + ((size_t)l * NBP + b) * 15 * 256) + i15 * 256 + c8;
            *(f32x4*)o = (f32x4){bf_lo(v.x), bf_hi(v.x), bf_lo(v.y), bf_hi(v.y)}; *(f32x4*)(o + 4) = (f32x4){bf_lo(v.z), bf_hi(v.z), bf_lo(v.w), bf_hi(v.w)}; }
        {
            const int cp = tid & 127, rq = tid >> 7;
            if (rq * 32 < L) {
                const int w = 2 << (cp >> 5);
                const LAS unsigned* pcol = (const LAS unsigned*)PB + cp;
                const int ts = rq * 32;
                float s0 = 0.f, s1 = 0.f;
                for (int jj = 0; jj < w; ++jj) { const unsigned v = pcol[(15 + ts - jj) * 128]; s0 += bf_lo(v); s1 += bf_hi(v); }
#pragma unroll 4
                for (int t = ts; t < ts + 32; ++t) {
                    const unsigned v = pcol[(15 + t) * 128];
                    if (t > ts) { const unsigned vo = pcol[(15 + t - w) * 128]; s0 += bf_lo(v) - bf_lo(vo); s1 += bf_hi(v) - bf_hi(vo); }
                    const int pos = pos0 + t; const float cnt = (float)((pos + 1 < w) ? pos + 1 : w); const float ic = __builtin_amdgcn_rcpf(cnt);
                    const float d0 = s0 * ic - bf_lo(v), d1 = s1 * ic - bf_hi(v);
                    *((LAS unsigned*)(DM + t * 264) + cp) = cvt_pk_bf16(d0, d1);
                }
            }
        }
        __syncthreads();
        if (w8 * 16 < L) {
            bf16_t* yr = Y + (size_t)(r0 + 16 * w8 + fr) * D + 512;
#pragma unroll 1
            for (int g = 0; g < 4; ++g) {
                f32x4 acc[4];
#pragma unroll
                for (int dt = 0; dt < 4; ++dt) acc[dt] = (f32x4){0.f, 0.f, 0.f, 0.f};
#pragma unroll
                for (int ks = 0; ks < 2; ++ks) {
                    const bf16x8 yf = *(const LAS bf16x8*)(DM + (16 * w8 + fr) * 264 + 64 * g + 32 * ks + 8 * fq);
#pragma unroll
                    for (int dt = 0; dt < 4; ++dt) { const bf16x8 xf = *(const bf16x8*)(WPT + ((size_t)g * 64 + 16 * dt + fr) * 64 + 32 * ks + 8 * fq);
                        acc[dt] = __builtin_amdgcn_mfma_f32_16x16x32_bf16(xf, yf, acc[dt], 0, 0, 0); }
                }
#pragma unroll
                for (int dt = 0; dt < 4; ++dt) { const int col = 64 * g + 16 * dt + 4 * fq; const f32x4 sc = *(const f32x4*)(pscale + col); const f32x4 v = acc[dt] * sc;
                    u32x2 w; w.x = cvt_pk_bf16(v[0], v[1]); w.y = cvt_pk_bf16(v[2], v[3]); *(u32x2*)(yr + col) = w; }
            }
        }
        }
        asm volatile("" ::: "memory");
#pragma unroll 1
        for (int h = h0; h < h1; ++h) {
            const bool actw = (w8 * 16 < L);
            const int sl = (L == 128 && (h & 1)) ? 7 - w8 : w8;
            const int q = 16 * sl + fr, nks = sl / 2 + 1;
            const int nvi = (L == 128) ? 4 : 1;
            const int vk = (L == 128) ? 16 * w8 + (lane & 15) : 16 * (w8 & 1) + (lane & 15);
            u32x4 vreg[4];
#pragma unroll
            for (int i = 0; i < 4; ++i) if (i < nvi) { const int d8 = 8 * (4 * ((L == 128) ? i : (w8 >> 1)) + (lane >> 4));
                vreg[i] = *(const u32x4*)(Z + (size_t)(r0 + vk) * DIN + 512 + 128 * h + d8); }
            bf16x8 wfr[4]; u32x4 uu[4]; float bs = 0.f;
            if (actw) {
#pragma unroll
                for (int ks = 0; ks < 4; ++ks) if (ks < nks) wfr[ks] = *(const bf16x8*)(WSB + ((size_t)h * 128 + q) * 128 + 32 * ks + 8 * fq);
                const bf16_t* ur = Z + (size_t)(r0 + q) * DIN + 128 * h;
#pragma unroll
                for (int j = 0; j < 4; ++j) uu[j] = *(const u32x4*)(ur + 32 * j + 8 * fq);
                bs = b_s[h * 128 + q];
            }
            __syncthreads();
#pragma unroll
            for (int i = 0; i < 4; ++i) if (i < nvi) { const int d8 = 8 * (4 * ((L == 128) ? i : (w8 >> 1)) + (lane >> 4)); const u32x4 v = vreg[i];
                LAS bf16_t* o = VT + d8 * 136 + vk;
                o[0 * 136] = (bf16_t)(v.x & 0xffffu); o[1 * 136] = (bf16_t)(v.x >> 16); o[2 * 136] = (bf16_t)(v.y & 0xffffu); o[3 * 136] = (bf16_t)(v.y >> 16);
                o[4 * 136] = (bf16_t)(v.z & 0xffffu); o[5 * 136] = (bf16_t)(v.z >> 16); o[6 * 136] = (bf16_t)(v.w & 0xffffu); o[7 * 136] = (bf16_t)(v.w >> 16); }
            __syncthreads();
            if (actw) {
                f32x4 acc[8];
#pragma unroll
                for (int dt = 0; dt < 8; ++dt) acc[dt] = (f32x4){0.f, 0.f, 0.f, 0.f};
#pragma unroll
                for (int ks = 0; ks < 4; ++ks) if (ks < nks) {
                    const int k0 = 32 * ks + 8 * fq;
                    const bf16x8 wf = wfr[ks];
#pragma unroll
                    for (int dt = 0; dt < 8; ++dt) { const bf16x8 vf = *(const LAS bf16x8*)(VT + (32 * (dt >> 1) + 8 * (fr >> 2) + 4 * (dt & 1) + (fr & 3)) * 136 + k0);
                        acc[dt] = __builtin_amdgcn_mfma_f32_16x16x32_bf16(vf, wf, acc[dt], 0, 0, 0); }
                }
                bf16_t* yr = Y + (size_t)(r0 + q) * D + 128 * h;
#pragma unroll
                for (int j = 0; j < 4; ++j) { const u32x4 u4 = uu[j]; const f32x4 a0 = acc[2 * j], a1 = acc[2 * j + 1];
                    u32x4 w;
                    w.x = cvt_pk_bf16(bf_lo(u4.x) * (a0[0] + bs), bf_hi(u4.x) * (a0[1] + bs)); w.y = cvt_pk_bf16(bf_lo(u4.y) * (a0[2] + bs), bf_hi(u4.y) * (a0[3] + bs));
                    w.z = cvt_pk_bf16(bf_lo(u4.z) * (a1[0] + bs), bf_hi(u4.z) * (a1[1] + bs)); w.w = cvt_pk_bf16(bf_lo(u4.w) * (a1[2] + bs), bf_hi(u4.w) * (a1[3] + bs));
                    *(u32x4*)(yr + 32 * j + 8 * fq) = w; }
            }
        }
    }
    __syncthreads();
}

template <int NB, int NM, int U>
__device__ __forceinline__ void thin_kloop(f32x4 (&acc)[NB][NM], const bf16_t* (&wp)[NB], const bf16_t* (&ap)[NM], int kbeg, int kend) {
#pragma unroll 1
    for (int k = kbeg; k < kend; k += 32 * U) {
        bf16x8 wf[U][NB], af[U][NM];
#pragma unroll
        for (int u = 0; u < U; ++u) if (k + 32 * u < kend) {
#pragma unroll
            for (int nb = 0; nb < NB; ++nb) wf[u][nb] = *(const bf16x8*)(wp[nb] + k + 32 * u);
#pragma unroll
            for (int nm = 0; nm < NM; ++nm) af[u][nm] = *(const bf16x8*)(ap[nm] + k + 32 * u);
        }
        __builtin_amdgcn_sched_barrier(0);
#pragma unroll
        for (int u = 0; u < U; ++u) if (k + 32 * u < kend) {
#pragma unroll
            for (int nb = 0; nb < NB; ++nb)
#pragma unroll
                for (int nm = 0; nm < NM; ++nm) acc[nb][nm] = __builtin_amdgcn_mfma_f32_16x16x32_bf16(wf[u][nb], af[u][nm], acc[nb][nm], 0, 0, 0);
        }
        __builtin_amdgcn_sched_barrier(0);
    }
}
__device__ __forceinline__ void thin_z(LAS unsigned char* lds, const bf16_t* XB, const bf16_t* Wt, const float* ssq, bf16_t* Z) {
    if (blockIdx.x >= 128) return;
    int tid = threadIdx.x; asm volatile("" : "+v"(tid));
    const int lane = tid & 63, w = __builtin_amdgcn_readfirstlane(tid >> 6), fr = lane & 15, fq = lane >> 4;
    const int b = blockIdx.x >> 4, cgp = blockIdx.x & 15, r0 = RP + 32 * b;
    const float rs0 = rstd_of(ssq + (size_t)(r0 + fr) * 16), rs1 = rstd_of(ssq + (size_t)(r0 + 16 + fr) * 16);
    f32x4 acc[8][2];
    const bf16_t* wp[8];
#pragma unroll
    for (int nb = 0; nb < 8; ++nb) { acc[nb][0] = (f32x4){0.f, 0.f, 0.f, 0.f}; acc[nb][1] = (f32x4){0.f, 0.f, 0.f, 0.f}; wp[nb] = Wt + (size_t)(16 * (cgp * 8 + nb) + fr) * D + 8 * fq; }
    const bf16_t* ap[2] = {XB + (size_t)(r0 + fr) * D + 8 * fq, XB + (size_t)(r0 + 16 + fr) * D + 8 * fq};
    thin_kloop<8, 2, 2>(acc, wp, ap, w * (D / 8), (w + 1) * (D / 8));
    LAS f32x4* red = (LAS f32x4*)lds;
#pragma unroll
    for (int nb = 0; nb < 8; ++nb)
#pragma unroll
        for (int nm = 0; nm < 2; ++nm) red[(w * 16 + nb * 2 + nm) * 64 + lane] = acc[nb][nm];
    __syncthreads();
#pragma unroll
    for (int nm = 0; nm < 2; ++nm) {
        f32x4 s = (f32x4){0.f, 0.f, 0.f, 0.f};
#pragma unroll
        for (int sw = 0; sw < 8; ++sw) s += red[(sw * 16 + w * 2 + nm) * 64 + lane];
        const int r = r0 + 16 * nm + fr; const f32x4 v = s * (nm ? rs1 : rs0);
        u32x2 o; o.x = cvt_pk_bf16(v[0], v[1]); o.y = cvt_pk_bf16(v[2], v[3]); *(u32x2*)(Z + (size_t)r * DIN + 16 * (cgp * 8 + w) + 4 * fq) = o;
    }
    __syncthreads();
}
__device__ __forceinline__ void thin_res(LAS unsigned char* lds, const bf16_t* A, const bf16_t* Wt, int K, bf16_t* XB, float* ssq, float* xout) {
    if (blockIdx.x >= 128) return;
    int tid = threadIdx.x; asm volatile("" : "+v"(tid));
    const int lane = tid & 63, w = __builtin_amdgcn_readfirstlane(tid >> 6), fr = lane & 15, fq = lane >> 4;
    const int b = blockIdx.x >> 4, cgp = blockIdx.x & 15, r0 = RP + 32 * b, cb = cgp * 4 + (w & 3), nm = w >> 2;
    const int col = 16 * cb + 4 * fq; const size_t r = (size_t)r0 + 16 * nm + fr;
    const u32x2 xv = *(const u32x2*)(XB + r * D + col);
    f32x4 acc[4][2];
    const bf16_t* wp[4];
#pragma unroll
    for (int nb = 0; nb < 4; ++nb) { acc[nb][0] = (f32x4){0.f, 0.f, 0.f, 0.f}; acc[nb][1] = (f32x4){0.f, 0.f, 0.f, 0.f}; wp[nb] = Wt + (size_t)(16 * (cgp * 4 + nb) + fr) * K + 8 * fq; }
    const bf16_t* ap[2] = {A + (size_t)(r0 + fr) * K + 8 * fq, A + (size_t)(r0 + 16 + fr) * K + 8 * fq};
    const int kslice = K / 8;
    thin_kloop<4, 2, 4>(acc, wp, ap, w * kslice, (w + 1) * kslice);
    LAS f32x4* red = (LAS f32x4*)lds;
#pragma unroll
    for (int nb = 0; nb < 4; ++nb)
#pragma unroll
        for (int m2 = 0; m2 < 2; ++m2) red[(w * 8 + nb * 2 + m2) * 64 + lane] = acc[nb][m2];
    __syncthreads();
    f32x4 s = (f32x4){0.f, 0.f, 0.f, 0.f};
#pragma unroll
    for (int sw = 0; sw < 8; ++sw) s += red[(sw * 8 + (w & 3) * 2 + nm) * 64 + lane];
    const f32x4 x = (f32x4){bf_lo(xv.x), bf_hi(xv.x), bf_lo(xv.y), bf_hi(xv.y)} + s;
    if (xout) *(f32x4*)(xout + r * D + col) = x;
    else { u32x2 o; o.x = cvt_pk_bf16(x[0], x[1]); o.y = cvt_pk_bf16(x[2], x[3]); *(u32x2*)(XB + r * D + col) = o; }
    float q = (x[0] * x[0] + x[1] * x[1]) + (x[2] * x[2] + x[3] * x[3]);
    q += __shfl_xor(q, 16); q += __shfl_xor(q, 32);
    LAS float* part = (LAS float*)(lds + pg8::STAGE_BYTES + 2048);
    if (fq == 0) part[w * 16 + fr] = q;
    __syncthreads();
    if (tid < 32) { const int m2 = tid >> 4, f2 = tid & 15; const float sq = (part[(m2 * 4 + 0) * 16 + f2] + part[(m2 * 4 + 1) * 16 + f2]) + (part[(m2 * 4 + 2) * 16 + f2] + part[(m2 * 4 + 3) * 16 + f2]);
        ssq[((size_t)r0 + tid) * 16 + cgp] = sq; }
    __syncthreads();
}
__device__ __forceinline__ void thin_act(const bf16_t* XB, const bf16_t* Wt, const float* ssq, bf16_t* ACT, const float* wf, const float* bfc, const float* st_ffn_l, float* out_ffns_l) {
    if (blockIdx.x >= 256) return;
    int tid = threadIdx.x; asm volatile("" : "+v"(tid));
    const int lane = tid & 63, w = __builtin_amdgcn_readfirstlane(tid >> 6), fr = lane & 15, fq = lane >> 4;
    const int b = blockIdx.x >> 5, cgp = (blockIdx.x >> 1) & 15, half = blockIdx.x & 1, r0 = RP + 32 * b;
    const int j = half * 6 + w;
    if (w < 6 && j < 11) {
        const int P = cgp * 11 + j, cg = 16 * P;
        const int wrow = (cg >> 7) * 256 + (cg & 127);
        const int c4 = cg + 4 * fq;
        const float rs0 = rstd_of(ssq + (size_t)(r0 + fr) * 16), rs1 = rstd_of(ssq + (size_t)(r0 + 16 + fr) * 16);
        f32x4 w0[2], w1[2], w2[2], bb[2], prev[2];
#pragma unroll
        for (int bj = 0; bj < 2; ++bj) { const int col = bj * DFF + c4;
            w0[bj] = *(const f32x4*)(wf + col); w1[bj] = *(const f32x4*)(wf + DUP + col); w2[bj] = *(const f32x4*)(wf + 2 * DUP + col); bb[bj] = *(const f32x4*)(bfc + col);
            prev[bj] = (fr >= 14) ? *(const f32x4*)(st_ffn_l + ((size_t)b * 2 + (fr - 14)) * DUP + col) : (f32x4){0.f, 0.f, 0.f, 0.f}; }
        f32x4 acc[2][2];
#pragma unroll
        for (int a = 0; a < 2; ++a)
#pragma unroll
            for (int c = 0; c < 2; ++c) acc[a][c] = (f32x4){0.f, 0.f, 0.f, 0.f};
        const bf16_t* wp[2] = {Wt + (size_t)(wrow + fr) * D + 8 * fq, Wt + (size_t)(wrow + 128 + fr) * D + 8 * fq};
        const bf16_t* ap[2] = {XB + (size_t)(r0 + fr) * D + 8 * fq, XB + (size_t)(r0 + 16 + fr) * D + 8 * fq};
        thin_kloop<2, 2, 8>(acc, wp, ap, 0, D);
#pragma unroll
        for (int nm = 0; nm < 2; ++nm) {
            f32x4 cur[2], o[2];
#pragma unroll
            for (int bj = 0; bj < 2; ++bj) { cur[bj] = acc[bj][nm] * (nm ? rs1 : rs0);
#pragma unroll
                for (int e = 0; e < 4; ++e) { const float c0 = cur[bj][e], p0 = prev[bj][e];
                    const float u1 = dpp_ror1(fr == 15 ? p0 : c0), u2 = dpp_ror2(fr >= 14 ? p0 : c0);
                    o[bj][e] = bb[bj][e] + w0[bj][e] * u2 + w1[bj][e] * u1 + w2[bj][e] * c0; } }
            f32x4 a0;
#pragma unroll
            for (int e = 0; e < 4; ++e) { const float g0 = o[0][e]; a0[e] = g0 * o[1][e] * __builtin_amdgcn_rcpf(1.0f + __builtin_amdgcn_exp2f(-1.4426950408889634f * g0)); }
            u32x2 ov; ov.x = cvt_pk_bf16(a0[0], a0[1]); ov.y = cvt_pk_bf16(a0[2], a0[3]);
            *(u32x2*)(ACT + (size_t)(r0 + 16 * nm + fr) * DFF + c4) = ov;
            if (nm == 1 && fr >= 14) {
#pragma unroll
                for (int bj = 0; bj < 2; ++bj) *(f32x4*)(out_ffns_l + ((size_t)b * 2 + (fr - 14)) * DUP + bj * DFF + c4) = cur[bj]; }
            prev[0] = cur[0]; prev[1] = cur[1];
        }
    }
}

__device__ __forceinline__ void fixup_phase(KP pk, int l) {
    const Params p = load_params(pk);
    int tid = threadIdx.x; asm volatile("" : "+v"(tid));
    unsigned char* ws = p.ws;
    const float* halo = (const float*)(ws + WS_HALO);
    bf16_t* ACT = (bf16_t*)(ws + WS_ACT);
    const float* wf = p.in[15] + (size_t)l * 3 * DUP; const float* bfc = p.in[16] + (size_t)l * DUP;
    float* out = p.out;
    const int c8 = tid * 8;
    if (c8 < DFF) {
        f32x4 bg[2], ba[2], wg[3][2], wa[3][2];
#pragma unroll
        for (int hh = 0; hh < 2; ++hh) { bg[hh] = *(const f32x4*)(bfc + c8 + 4 * hh); ba[hh] = *(const f32x4*)(bfc + DFF + c8 + 4 * hh);
#pragma unroll
            for (int d = 0; d < 3; ++d) { wg[d][hh] = *(const f32x4*)(wf + d * DUP + c8 + 4 * hh); wa[d][hh] = *(const f32x4*)(wf + d * DUP + DFF + c8 + 4 * hh); } }
        for (int idx = blockIdx.x; idx < 1024; idx += 2 * gridDim.x) {
            f32x4 xg[2][3][2], xa[2][3][2]; size_t rowi[2]; bool valid[2];
#pragma unroll
            for (int s = 0; s < 2; ++s) { const int id = idx + s * gridDim.x; valid[s] = id < 1024;
                const int seg = (valid[s] ? id : idx) >> 1, j = id & 1; rowi[s] = (size_t)seg * 64 + j;
                const float* u0 = halo + (size_t)seg * 4 * DUP; const float* u1 = u0 + DUP;
                const bool first = (seg & 255) == 0;
                const float* um2 = halo + ((size_t)(first ? seg : seg - 1) * 4 + 2) * DUP; const float* um1 = um2 + DUP;
                const float* p0 = j ? u1 : u0; const float* p1 = j ? u0 : um1; const float* p2 = j ? um1 : um2;
                const bool z1 = first && j == 0, z2 = first;
#pragma unroll
                for (int hh = 0; hh < 2; ++hh) {
                    xg[s][2][hh] = *(const f32x4*)(p0 + c8 + 4 * hh); xa[s][2][hh] = *(const f32x4*)(p0 + DFF + c8 + 4 * hh);
                    xg[s][1][hh] = z1 ? (f32x4){0.f, 0.f, 0.f, 0.f} : *(const f32x4*)(p1 + c8 + 4 * hh); xa[s][1][hh] = z1 ? (f32x4){0.f, 0.f, 0.f, 0.f} : *(const f32x4*)(p1 + DFF + c8 + 4 * hh);
                    xg[s][0][hh] = z2 ? (f32x4){0.f, 0.f, 0.f, 0.f} : *(const f32x4*)(p2 + c8 + 4 * hh); xa[s][0][hh] = z2 ? (f32x4){0.f, 0.f, 0.f, 0.f} : *(const f32x4*)(p2 + DFF + c8 + 4 * hh); } }
#pragma unroll
            for (int s = 0; s < 2; ++s) if (valid[s]) {
                float v[8];
#pragma unroll
                for (int hh = 0; hh < 2; ++hh) { const f32x4 g4 = bg[hh] + wg[2][hh] * xg[s][2][hh] + wg[1][hh] * xg[s][1][hh] + wg[0][hh] * xg[s][0][hh];
                    const f32x4 a4 = ba[hh] + wa[2][hh] * xa[s][2][hh] + wa[1][hh] * xa[s][1][hh] + wa[0][hh] * xa[s][0][hh];
#pragma unroll
                    for (int e = 0; e < 4; ++e) v[4 * hh + e] = g4[e] * a4[e] * __builtin_amdgcn_rcpf(1.0f + __builtin_amdgcn_exp2f(-1.4426950408889634f * g4[e])); }
                u32x4 w; w.x = cvt_pk_bf16(v[0], v[1]); w.y = cvt_pk_bf16(v[2], v[3]); w.z = cvt_pk_bf16(v[4], v[5]); w.w = cvt_pk_bf16(v[6], v[7]);
                *(u32x4*)(ACT + rowi[s] * DFF + c8) = w; }
        }
    }
    if (blockIdx.x < 4) {
        const int k = blockIdx.x, b = k >> 1, j = k & 1;
        const float* src = halo + ((size_t)(256 * b + 255) * 4 + 2 + j) * DUP; float* dst = out + O_FFNP + (((size_t)l * NBP + b) * 2 + j) * DUP;
        for (int c = tid * 4; c < DUP; c += 512 * 4) *(f32x4*)(dst + c) = *(const f32x4*)(src + c);
    }
}

__device__ __forceinline__ void final_phase(KP pk) {
    const Params p = load_params(pk);
    const int tid = threadIdx.x, lane = tid & 63, wave = tid >> 6;
    const int gw = blockIdx.x * 8 + wave, NGW = gridDim.x * 8;
    const float* g = p.in[18];
    const bf16_t* XB = (const bf16_t*)(p.ws + WS_XB); const float* ssq = (const float*)(p.ws + WS_SSQ);
    f32x4 gg[2][2];
#pragma unroll
    for (int j = 0; j < 2; ++j) { gg[j][0] = *(const f32x4*)(g + 512 * j + 8 * lane); gg[j][1] = *(const f32x4*)(g + 512 * j + 8 * lane + 4); }
    for (int rb = gw; rb < R; rb += 4 * NGW) {
        u32x4 xv[4][2]; f32x4 sq[4][4];
#pragma unroll
        for (int i = 0; i < 4; ++i) { const int r = rb + i * NGW; if (r < R) {
#pragma unroll
            for (int k = 0; k < 4; ++k) sq[i][k] = *(const f32x4*)(ssq + (size_t)r * 16 + 4 * k);
#pragma unroll
            for (int j = 0; j < 2; ++j) xv[i][j] = *(const u32x4*)(XB + (size_t)r * D + 512 * j + 8 * lane); } }
#pragma unroll
        for (int i = 0; i < 4; ++i) { const int r = rb + i * NGW; if (r < R) {
            const f32x4 a = sq[i][0], b4 = sq[i][1], c = sq[i][2], d = sq[i][3];
            const float s = ((a.x + a.y) + (a.z + a.w)) + ((b4.x + b4.y) + (b4.z + b4.w)) + ((c.x + c.y) + (c.z + c.w)) + ((d.x + d.y) + (d.z + d.w));
            const float rs = rsqrtf(s * (1.0f / D) + EPS);
            float* yr = p.out + (size_t)r * D;
#pragma unroll
            for (int j = 0; j < 2; ++j) { const u32x4 v = xv[i][j];
                *(f32x4*)(yr + 512 * j + 8 * lane) = (f32x4){bf_lo(v.x), bf_hi(v.x), bf_lo(v.y), bf_hi(v.y)} * rs * gg[j][0];
                *(f32x4*)(yr + 512 * j + 8 * lane + 4) = (f32x4){bf_lo(v.z), bf_hi(v.z), bf_lo(v.w), bf_hi(v.w)} * rs * gg[j][1]; } } }
    }
}

#define XB_TMO      128
#define XB_XCNT(j)  (256  + 64 * (j))
#define XB_XSUB(j)  (1280 + 64 * (j))
#define XB_XGEN(j)  (2304 + 64 * (j))
#define XB_TOP      3328
#define XB_TOPGEN   3392
#define XCD_BAR_WORDS 3456
#define XB_SPIN_CAP (1u << 22)
__device__ __forceinline__ unsigned xb_ld(unsigned* p)              { return __hip_atomic_load(p, __ATOMIC_RELAXED, __HIP_MEMORY_SCOPE_AGENT); }
__device__ __forceinline__ unsigned xb_add(unsigned* p, unsigned v) { return __hip_atomic_fetch_add(p, v, __ATOMIC_RELAXED, __HIP_MEMORY_SCOPE_AGENT); }
__device__ __forceinline__ unsigned xb_xcc_id() { return (unsigned)__builtin_amdgcn_s_getreg((3 << 11) | 20) & 0xFu; }
#define XB_SPIN(cond, bar) do { unsigned _sp = 0; while (cond) { __builtin_amdgcn_s_sleep(1); \
    if ((++_sp & 255u) == 0u) { if (xb_ld(&(bar)[XB_TMO])) break; if (_sp > XB_SPIN_CAP) { atomicAdd(&(bar)[XB_TMO], 1u); break; } } } } while (0)
struct XcdBarrier { unsigned* bar; unsigned x; volatile LAS unsigned* st; };
__device__ __forceinline__ XcdBarrier xcd_barrier_post(unsigned* bar, volatile LAS unsigned* st) {
    XcdBarrier b; b.bar = bar; b.x = xb_xcc_id(); b.st = st;
    if (threadIdx.x == 0) (void)xb_add(&bar[XB_XCNT(b.x)], 1u);
    return b;
}
__device__ __forceinline__ void xcd_barrier_complete(unsigned* bar, unsigned x, unsigned& nloc, unsigned& nx) {
    const unsigned G = gridDim.x * gridDim.y * gridDim.z;
    unsigned sum, cnt, mine, sp = 0u;
    for (;;) {
        sum = 0u; cnt = 0u; mine = 0u;
#pragma unroll
        for (unsigned j = 0; j < 16; ++j) { const unsigned c = xb_ld(&bar[XB_XCNT(j)]); sum += c; cnt += (c > 0u) ? 1u : 0u; mine = (j == x) ? c : mine; }
        if (sum == G) break;
        __builtin_amdgcn_s_sleep(1);
        if ((++sp & 255u) == 0u) { if (xb_ld(&bar[XB_TMO])) break; if (sp > XB_SPIN_CAP) { atomicAdd(&bar[XB_TMO], 1u); break; } }
    }
    nloc = mine > 0u ? mine : 1u; nx = cnt > 0u ? cnt : 1u;
}
__device__ __forceinline__ void xcd_barrier(const XcdBarrier& b) {
    asm volatile("s_waitcnt vmcnt(0)" ::: "memory");
    __syncthreads();
    if (threadIdx.x == 0) {
        unsigned* bar = b.bar;
        __builtin_amdgcn_s_waitcnt(0);
        unsigned nloc = b.st[0], nx = b.st[1];
        if (nloc == 0u) { xcd_barrier_complete(bar, b.x, nloc, nx); b.st[0] = nloc; b.st[1] = nx; }
        const unsigned old = xb_add(&bar[XB_XSUB(b.x)], 1u);
        const unsigned gen = old / nloc;
        if (old + 1u == (gen + 1u) * nloc) {
            __builtin_amdgcn_fence(__ATOMIC_RELEASE, "agent");
            asm volatile("s_waitcnt vmcnt(0)" ::: "memory");
            const unsigned og = xb_add(&bar[XB_TOP], 1u);
            const unsigned tg = og / nx;
            if (og + 1u == (tg + 1u) * nx) xb_add(&bar[XB_TOPGEN], 1u);
            else XB_SPIN(xb_ld(&bar[XB_TOPGEN]) == tg, bar);
            __builtin_amdgcn_fence(__ATOMIC_ACQUIRE, "agent");
            xb_add(&bar[XB_XGEN(b.x)], 1u);
            asm volatile("s_waitcnt vmcnt(0)" ::: "memory");
        } else {
            XB_SPIN(xb_ld(&bar[XB_XGEN(b.x)]) == gen, bar);
            __builtin_amdgcn_fence(__ATOMIC_ACQUIRE, "agent");
            asm volatile("s_waitcnt vmcnt(0)" ::: "memory");
        }
    }
    __syncthreads();
}

__global__ void __launch_bounds__(512, 2) fwd_megakernel(Params p_unused) {
    extern __shared__ __attribute__((aligned(16))) unsigned char lds_raw[];
    LAS unsigned char* lds = (LAS unsigned char*)lds_raw;
    cg::grid_group grid = cg::this_grid();
    volatile LAS unsigned* bst = (volatile LAS unsigned*)(lds + LDS_BYTES - 16);
    if (threadIdx.x == 0) { bst[0] = 0u; bst[1] = 0u; }
    __syncthreads();
    const XcdBarrier xbar = xcd_barrier_post((unsigned*)(kparams()->ws + WS_BAR), bst);

#ifndef NO_PRO
    prologue(lds, kparams());
#endif
    if (kparams()->ws == nullptr) grid.sync();
    { XcdBarrier xb_; xb_.bar = (unsigned*)(kparams()->ws + WS_BAR); xb_.x = xb_xcc_id(); xb_.st = (volatile LAS unsigned*)(lds + LDS_BYTES - 16); xcd_barrier(xb_); }
#pragma unroll 1
    for (int l = 0; l < NLAYER; ++l) {
        {
            KP q = kparams(); unsigned char* ws = q->ws; const int G = gridDim.x, c = blockIdx.x;
            bf16_t* XB = (bf16_t*)(ws + WS_XB); float* ssq = (float*)(ws + WS_SSQ); bf16_t* Z = (bf16_t*)(ws + WS_Z);
            pg8::Gemm g{XB, (const bf16_t*)(ws + WS_WIN) + (size_t)l * DIN * D, D}; pg8::Order S; S.init(DIN, G, c);
            pg8::EpiZ E{Z, ssq, (LAS float*)(lds + pg8::STAGE_BYTES), -1};
#ifndef NO_THIN
            thin_z(lds, XB, g.Bt, ssq, Z);
#endif
#ifndef NO_G1
            pg8::gemm_phase<pg8::EpiZ, pg8::Order, true, true>(lds, g, S, E);
#endif
        }
        xcd_barrier(xbar);
#ifndef NO_MIX
        mixer_phase(lds, kparams(), l);
#endif
        xcd_barrier(xbar);
        {
            KP q = kparams(); unsigned char* ws = q->ws; const int G = gridDim.x, c = blockIdx.x;
            bf16_t* XB = (bf16_t*)(ws + WS_XB); float* ssq = (float*)(ws + WS_SSQ); bf16_t* Y = (bf16_t*)(ws + WS_Y);
            pg8::Gemm g{Y, (const bf16_t*)(ws + WS_WOUT) + (size_t)l * D * D, D}; pg8::Order S; S.init(D, G, c);
            pg8::EpiRes E{XB, ssq, nullptr};
#ifndef NO_THIN
            thin_res(lds, Y, g.Bt, D, XB, ssq, nullptr);
#endif
#ifndef NO_G24
            pg8::gemm_phase<pg8::EpiRes, pg8::Order, true, true>(lds, g, S, E);
#endif
        }
        xcd_barrier(xbar);
        {
            KP q = kparams(); unsigned char* ws = q->ws; const int G = gridDim.x, c = blockIdx.x;
            bf16_t* XB = (bf16_t*)(ws + WS_XB); float* ssq = (float*)(ws + WS_SSQ); bf16_t* ACT = (bf16_t*)(ws + WS_ACT);
            pg8::Gemm g{XB, (const bf16_t*)(ws + WS_WUP) + (size_t)l * DUP * D, D}; pg8::Order S; S.init(DUP, G, c);
            pg8::EpiAct E{ACT, ssq, (float*)(ws + WS_HALO), q->in[15] + (size_t)l * 3 * DUP, q->in[16] + (size_t)l * DUP, (LAS float*)(lds + pg8::STAGE_BYTES), -1};
#ifndef NO_THINA
            thin_act(XB, g.Bt, ssq, ACT, E.wf, E.bfc, q->in[4] + (size_t)l * NBS * 2 * DUP, q->out + O_FFNS + (size_t)l * NBS * 2 * DUP);
#endif
#ifndef NO_G3
            pg8::gemm_phase<pg8::EpiAct, pg8::Order, true, true>(lds, g, S, E);
#endif
        }
        xcd_barrier(xbar);
#ifndef NO_FIX
        fixup_phase(kparams(), l);
#endif
        xcd_barrier(xbar);
        {
            KP q = kparams(); unsigned char* ws = q->ws; const int G = gridDim.x, c = blockIdx.x;
            bf16_t* XB = (bf16_t*)(ws + WS_XB); float* ssq = (float*)(ws + WS_SSQ); bf16_t* ACT = (bf16_t*)(ws + WS_ACT);
            pg8::Gemm g{ACT, (const bf16_t*)(ws + WS_WDN) + (size_t)l * D * DFF, DFF}; pg8::Order S; S.init(D, G, c);
            pg8::EpiRes E{XB, ssq, nullptr};
#ifndef NO_THIN
            thin_res(lds, ACT, g.Bt, DFF, XB, ssq, E.xout);
#endif
#ifndef NO_G24
            pg8::gemm_phase<pg8::EpiRes, pg8::Order, true, true>(lds, g, S, E);
#endif
        }
        xcd_barrier(xbar);
    }
    final_phase(kparams());
}

extern "C" void kernel_launch(void* const* d_in, const int* in_sizes, int n_in, void* d_out, int out_size, void* d_ws, size_t ws_size, hipStream_t stream) {
    static int grid = 0;
    if (grid == 0) {
        int dev = 0, cus = 0, per_cu = 0;
        (void)hipGetDevice(&dev);
        (void)hipDeviceGetAttribute(&cus, hipDeviceAttributeMultiprocessorCount, dev);
        (void)hipFuncSetAttribute((const void*)fwd_megakernel, hipFuncAttributeMaxDynamicSharedMemorySize, LDS_BYTES);
        (void)hipOccupancyMaxActiveBlocksPerMultiprocessor(&per_cu, (const void*)fwd_megakernel, 512, LDS_BYTES);
        if (n_in != 19 || (size_t)out_size != O_END || ws_size < WS_END) { fprintf(stderr, "kernel_launch: unexpected shapes: n_in %d out_size %d ws_size %zu (need %zu)\n", n_in, out_size, ws_size, (size_t)WS_END); }
        if (per_cu < 1) { fprintf(stderr, "kernel_launch: occupancy query says %d blocks per CU\n", per_cu); per_cu = 1; }
        grid = cus > 0 ? cus : 256;
    }
    Params p{};
    for (int i = 0; i < 19; ++i) p.in[i] = (const float*)d_in[i];
    p.out = (float*)d_out; p.ws = (unsigned char*)d_ws;
    (void)hipMemsetAsync((unsigned char*)d_ws + WS_BAR, 0, 16384, stream);
    void* args[] = {&p};
    hipError_t e = hipLaunchCooperativeKernel((const void*)fwd_megakernel, dim3(grid), dim3(512), args, LDS_BYTES, stream);
    if (e != hipSuccess) fprintf(stderr, "cooperative launch failed: %s (grid %d)\n", hipGetErrorString(e), grid);
}
```
